# Optimizing an MI355X kernel written in HIP

```python
import math
import jax, jax.numpy as jnp
from jax import lax
import numpy as np

D_MODEL = 1024
BATCH = 32
SEQ = 2048
DEPTH = 2

EXPAND = 2
BRANCH_W = EXPAND * D_MODEL
N_A = DEPTH // 2
N_B = DEPTH - N_A
CHUNK = 128
GROUP_W = 128
N_GROUPS = BRANCH_W // GROUP_W
DIFF_HEAD_DIM = 128
N_DIFF_HEADS = BRANCH_W // (2 * DIFF_HEAD_DIM)
ATT_W = N_DIFF_HEADS * 2 * DIFF_HEAD_DIM
Q_BLOCK = 128
EPS = 1e-6

kernel_name = "yoco_gmlp_diffattn_hybrid"


def rmsnorm(x, g):
    x32 = x.astype(jnp.float32)
    y = x32 * lax.rsqrt(jnp.mean(x32 * x32, axis=-1, keepdims=True) + EPS)
    return (y * g.astype(jnp.float32)).astype(x.dtype)


def layernorm(x, g, b):
    x32 = x.astype(jnp.float32)
    mu = jnp.mean(x32, axis=-1, keepdims=True)
    xc = x32 - mu
    y = xc * lax.rsqrt(jnp.mean(xc * xc, axis=-1, keepdims=True) + EPS)
    return (y * g.astype(jnp.float32) + b.astype(jnp.float32)).astype(x.dtype)


def lambda_init_fn(layer_idx):
    return 0.8 - 0.6 * math.exp(-0.3 * layer_idx)


def mixer_a(hn, w_in, ln_g, ln_b, w_s, b_s, w_out):
    bsz, seq, _ = hn.shape
    u, v, z = jnp.split(hn @ w_in, 3, axis=-1)
    u = jax.nn.gelu(u)
    v = layernorm(jax.nn.gelu(v), ln_g, ln_b)
    vc = v.reshape(bsz, seq // CHUNK, CHUNK, N_GROUPS, GROUP_W)
    causal = jnp.tril(jnp.ones((CHUNK, CHUNK), dtype=bool))
    ws = jnp.where(causal[None], w_s, jnp.zeros((), w_s.dtype))
    sv = jnp.einsum('gts,bnsgc->bntgc', ws, vc) + jnp.transpose(b_s)[None, None, :, :, None]
    y = u * sv.reshape(bsz, seq, BRANCH_W) * jax.nn.silu(z)
    return y @ w_out


def shared_kv(h, kv_norm_g, w_kv):
    bsz, seq, _ = h.shape
    k, v = jnp.split(rmsnorm(h, kv_norm_g) @ w_kv, 2, axis=-1)
    k = k.reshape(bsz, seq, N_DIFF_HEADS, 2, DIFF_HEAD_DIM)
    v = v.reshape(bsz, seq, N_DIFF_HEADS, 2 * DIFF_HEAD_DIM)
    return k, v


def diff_attention(q, k, v, lam):
    seq = q.shape[1]
    scale = DIFF_HEAD_DIM ** -0.5
    outs = []
    for i in range(seq // Q_BLOCK):
        start, end = i * Q_BLOCK, (i + 1) * Q_BLOCK
        qs = q[:, start:end]
        ks = k[:, :end]
        vs = v[:, :end]
        s = jnp.einsum('bqhnd,bkhnd->bhnqk', qs, ks).astype(jnp.float32) * scale
        q_pos = jnp.arange(start, end)
        k_pos = jnp.arange(end)
        mask = k_pos[None, :] <= q_pos[:, None]
        s = jnp.where(mask, s, -jnp.inf)
        p = jax.nn.softmax(s, axis=-1)
        w = p[:, :, 0] - lam * p[:, :, 1]
        outs.append(jnp.einsum('bhqk,bkhe->bqhe', w.astype(vs.dtype), vs))
    return jnp.concatenate(outs, axis=1)


def mixer_b(hn, k, v, w_qz, lq1, lk1, lq2, lk2, subln_g, w_o, lam_init):
    bsz, seq, _ = hn.shape
    q, z = jnp.split(hn @ w_qz, 2, axis=-1)
    q = q.reshape(bsz, seq, N_DIFF_HEADS, 2, DIFF_HEAD_DIM)
    f32 = jnp.float32
    lam = (jnp.exp(jnp.sum(lq1.astype(f32) * lk1.astype(f32)))
           - jnp.exp(jnp.sum(lq2.astype(f32) * lk2.astype(f32))) + lam_init)
    o = diff_attention(q, k, v, lam)
    o = rmsnorm(o, subln_g) * (1.0 - lam_init)
    y = o.reshape(bsz, seq, ATT_W) * jax.nn.silu(z)
    return y @ w_o


def setup_inputs(seed: int = 0) -> dict:
    key = jax.random.key(seed)
    ks = jax.random.split(key, 24)
    f32 = jnp.float32
    D, E, d = D_MODEL, BRANCH_W, DIFF_HEAD_DIM
    nrm = lambda k, shape, s: jax.random.normal(k, shape, f32) * s
    return {
        "x": jax.random.normal(ks[0], (BATCH, SEQ, D), f32),
        "a_norm_g": 1.0 + nrm(ks[1], (N_A, D), 0.02),
        "a_w_in": nrm(ks[2], (N_A, D, 3 * E), D ** -0.5),
        "a_ln_g": 1.0 + nrm(ks[3], (N_A, E), 0.02),
        "a_ln_b": nrm(ks[4], (N_A, E), 0.02),
        "a_w_s": nrm(ks[5], (N_A, N_GROUPS, CHUNK, CHUNK), CHUNK ** -0.5),
        "a_b_s": 1.0 + nrm(ks[6], (N_A, N_GROUPS, CHUNK), 0.02),
        "a_w_out": nrm(ks[7], (N_A, E, D), E ** -0.5),
        "b_norm_g": 1.0 + nrm(ks[8], (N_B, D), 0.02),
        "b_w_qz": nrm(ks[9], (N_B, D, 2 * ATT_W), D ** -0.5),
        "b_lam_q1": nrm(ks[10], (N_B, d), 0.1),
        "b_lam_k1": nrm(ks[11], (N_B, d), 0.1),
        "b_lam_q2": nrm(ks[12], (N_B, d), 0.1),
        "b_lam_k2": nrm(ks[13], (N_B, d), 0.1),
        "b_subln_g": 1.0 + nrm(ks[14], (N_B, 2 * d), 0.02),
        "b_w_o": nrm(ks[15], (N_B, ATT_W, D), ATT_W ** -0.5),
        "kv_norm_g": 1.0 + nrm(ks[16], (D,), 0.02),
        "w_kv": nrm(ks[17], (D, 2 * ATT_W), D ** -0.5),
        "final_g": 1.0 + nrm(ks[18], (D,), 0.02),
    }


def reference(x, a_norm_g, a_w_in, a_ln_g, a_ln_b, a_w_s, a_b_s, a_w_out,
              b_norm_g, b_w_qz, b_lam_q1, b_lam_k1, b_lam_q2, b_lam_k2, b_subln_g, b_w_o,
              kv_norm_g, w_kv, final_g):
    h = x
    k_sh, v_sh = None, None
    for l in range(DEPTH):
        if l < N_A:
            h = h + mixer_a(rmsnorm(h, a_norm_g[l]), a_w_in[l], a_ln_g[l], a_ln_b[l],
                            a_w_s[l], a_b_s[l], a_w_out[l])
        else:
            if l == N_A:
                k_sh, v_sh = shared_kv(h, kv_norm_g, w_kv)
            j = l - N_A
            h = h + mixer_b(rmsnorm(h, b_norm_g[j]), k_sh, v_sh, b_w_qz[j],
                            b_lam_q1[j], b_lam_k1[j], b_lam_q2[j], b_lam_k2[j],
                            b_subln_g[j], b_w_o[j], lambda_init_fn(l))
    return rmsnorm(h, final_g)
```

```cpp
#include <hip/hip_runtime.h>
#include <hip/hip_cooperative_groups.h>
#include <cstdio>
#include <cstdint>
namespace cg = cooperative_groups;

#define LAS __attribute__((address_space(3)))
typedef unsigned short bf16_t;
typedef short bf16x8 __attribute__((ext_vector_type(8)));
typedef short bf16x4 __attribute__((ext_vector_type(4)));
typedef float f32x4 __attribute__((ext_vector_type(4)));
typedef float f32x16 __attribute__((ext_vector_type(16)));
typedef unsigned u32x4 __attribute__((ext_vector_type(4)));
typedef unsigned u32x2 __attribute__((ext_vector_type(2)));

constexpr int MT = 65536;
constexpr int DM = 1024;
constexpr int EW = 2048;
constexpr int SEQ = 2048;
constexpr float EPS = 1e-6f;
constexpr float LAM_INIT = 0.35550906759f;
constexpr float QSCALE = 0.08838834764831845f * 1.4426950408889634f;

constexpr size_t WS_CTL   = 0;
constexpr size_t WS_RSTD1 = 4096;
constexpr size_t WS_LNSUM = WS_RSTD1 + (size_t)MT * 4;
constexpr size_t WS_LNSQ  = WS_LNSUM + (size_t)MT * 4;
constexpr size_t WS_RSS2  = WS_LNSQ + (size_t)MT * 4;
constexpr size_t WS_RSS3  = WS_RSS2 + (size_t)MT * 4;
constexpr size_t WS_R0    = WS_RSS3 + (size_t)MT * 4;
constexpr size_t WS_WSB   = WS_R0 + 16 * 128 * 4;
constexpr size_t WS_WINT  = WS_WSB + 16 * 128 * 128 * 2;
constexpr size_t WS_WOUTT = WS_WINT + (size_t)6144 * 1024 * 2;
constexpr size_t WS_WBT   = WS_WOUTT + (size_t)1024 * 2048 * 2;
constexpr size_t WS_WOT   = WS_WBT + (size_t)8192 * 1024 * 2;
constexpr size_t WS_XB    = WS_WOT + (size_t)1024 * 2048 * 2;
constexpr size_t WS_UZ    = WS_XB + (size_t)MT * DM * 2;
constexpr size_t WS_GVT   = WS_UZ + (size_t)MT * EW * 2;
constexpr size_t WS_Q     = WS_GVT + (size_t)MT * EW * 2;
constexpr size_t WS_END   = WS_Q + (size_t)MT * EW * 2;

constexpr size_t WS_DUMMY = WS_END;
constexpr size_t DRY_MASK = ((size_t)1 << 22) - 1;
constexpr size_t WS_BAR = WS_END + ((size_t)60 << 20);
constexpr int XB_ST_OFF = 131072 + 4032;
constexpr int LDS_BYTES = 131072 + 4096;
constexpr int MISC_OFF = 131072;

__device__ __forceinline__ unsigned cvt_pk_bf16(float lo, float hi) { unsigned r; asm volatile("v_cvt_pk_bf16_f32 %0, %1, %2" : "=v"(r) : "v"(lo), "v"(hi)); return r; }
__device__ __forceinline__ float bf2f(unsigned short b) { return __uint_as_float(((unsigned)b) << 16); }
__device__ __forceinline__ float gelu_t(float x) {
    const float y = x * (1.0f + 0.044715f * x * x);
    const float e = __builtin_amdgcn_exp2f(-2.302208198f * y);
    return x * __builtin_amdgcn_rcpf(1.0f + e);
}
__device__ __forceinline__ float gelu_silu(float u, float z) {
    const float y = u * (1.0f + 0.044715f * u * u);
    const float ea = __builtin_amdgcn_exp2f(-2.302208198f * y), ez = __builtin_amdgcn_exp2f(-1.4426950408889634f * z);
    return (u * z) * __builtin_amdgcn_rcpf((1.0f + ea) * (1.0f + ez));
}
template <int CTRL> __device__ __forceinline__ float dppf(float x) { return __int_as_float(__builtin_amdgcn_update_dpp(0, __float_as_int(x), CTRL, 0xF, 0xF, true)); }
__device__ __forceinline__ float row16_sum(float x) { x += dppf<0xB1>(x); x += dppf<0x4E>(x); x += dppf<0x141>(x); x += dppf<0x140>(x); return x; }
__device__ __forceinline__ void pin(float& v) { asm volatile("" : "+v"(v)); }
__device__ __forceinline__ void pin4(f32x4& v) { asm volatile("" : "+v"(v)); }
__device__ __forceinline__ void pinu4(u32x4& v) { asm volatile("" : "+v"(v)); }
__device__ __forceinline__ float silu_f(float z) { return z * __builtin_amdgcn_rcpf(1.0f + __builtin_amdgcn_exp2f(-1.4426950408889634f * z)); }

namespace pg8 {
constexpr int BM = 256, BK = 64, HALF = 128, HTB = HALF * BK * 2, STAGE_BYTES = 8 * HTB, NXCD = 8, WGM = 8;
__host__ __device__ __forceinline__ int lds_byte(int r, int c) { const int st = (r >> 4) * 2 + (c >> 5), rr = r & 15, cc = c & 31, ob = rr * 64 + cc * 2; return st * 1024 + (ob ^ (((ob >> 9) & 1) << 5)); }
__host__ __device__ __forceinline__ void stage_rc(int b, int& R, int& C) { const int st = b / 1024, sb = b % 1024, swz = sb ^ (((sb >> 9) & 1) << 5); R = (st >> 1) * 16 + swz / 64; C = (st & 1) * 32 + (swz % 64) / 2; }
__host__ __device__ __forceinline__ int perm32(int rho) { const int n = rho >> 4, i = rho & 15; return 8 * (i >> 2) + 4 * n + (i & 3); }

struct Unit { int pm, pn; };
struct Gemm { const bf16_t* A; const bf16_t* Bt; int M, N, K; };

struct StaticOrder {
    int nM, nN, nwg, G, c;
    __device__ void init(int M, int N, int G_, int c_) { nM = M / BM; nN = N / BM; nwg = nM * nN; G = G_; c = c_; }
    __device__ bool next(int i, Unit& u) const {
        const long L = (long)i * G + c; if (L >= nwg) return false;
        int wgid = (int)L; { const int q = nwg / NXCD, r = nwg % NXCD, xcd = wgid % NXCD, off = wgid / NXCD; wgid = (xcd < r ? xcd * (q + 1) : r * (q + 1) + (xcd - r) * q) + off; }
        const int nig = WGM * nN, gid = wgid / nig, fm = gid * WGM, gsz = (nM - fm) < WGM ? (nM - fm) : WGM;
        u.pm = fm + ((wgid % nig) % gsz); u.pn = (wgid % nig) / gsz; return true;
    }
};

template <class Epi>
__device__ __forceinline__ void gemm_phase(LAS unsigned char* lds, const Gemm g, const StaticOrder& S, const Epi& E) {
    const int tid = threadIdx.x, wid = __builtin_amdgcn_readfirstlane(tid >> 6), lane = tid & 63, wr = wid >> 2, wc = wid & 3, fr = lane & 15, fq = lane >> 4;
    const int K = g.K, nt = K / BK;
    unsigned voffA[2], voffB[2];
#pragma unroll
    for (int i = 0; i < 2; ++i) { int R, C; stage_rc(tid * 16 + i * 8192, R, C); const int Rb = Epi::PERM ? ((R & ~31) + perm32(R & 31)) : R;
        voffA[i] = (unsigned)(R * K + C) * 2u; voffB[i] = (unsigned)(Rb * K + C) * 2u; }
    const size_t kstep = (size_t)(BK * 2);
    const size_t hstep = (size_t)HALF * K * 2;
    const size_t tstep = 2 * hstep;
    const unsigned ldsw = (unsigned)wid * 1024u;
    const int aoff = lds_byte(wr * 64 + fr, fq * 8), boff = lds_byte(wc * 32 + fr, fq * 8);
#define PG8_SA(b, h) (((b) * 2 + (h)) * HTB)
#define PG8_SB(b, h) ((4 + (b) * 2 + (h)) * HTB)
#define PG8_STAGE(bufoff, gbase, voff) do { _Pragma("unroll") for (int _i = 0; _i < 2; ++_i) \
        __builtin_amdgcn_global_load_lds((const unsigned*)((const char*)(gbase) + (voff)[_i]), (LAS unsigned*)(lds + (bufoff) + ldsw + _i * 8192), 16, 0, 0); } while (0)
#define PG8_LDA(dst, b, h) do { _Pragma("unroll") for (int m = 0; m < 4; ++m) _Pragma("unroll") for (int k = 0; k < 2; ++k) dst[m][k] = *(const LAS bf16x8*)(lds + PG8_SA(b, h) + aoff + m * 2048 + k * 1024); } while (0)
#define PG8_LDB(dst, b, h) do { _Pragma("unroll") for (int n = 0; n < 2; ++n) _Pragma("unroll") for (int k = 0; k < 2; ++k) dst[n][k] = *(const LAS bf16x8*)(lds + PG8_SB(b, h) + boff + n * 2048 + k * 1024); } while (0)
#define PG8_MMA(ai, bj, At, Bt) do { _Pragma("unroll") for (int m = 0; m < 4; ++m) _Pragma("unroll") for (int n = 0; n < 2; ++n) _Pragma("unroll") for (int k = 0; k < 2; ++k) \
        acc[ai][bj][m][n] = Epi::SWAP ? __builtin_amdgcn_mfma_f32_16x16x32_bf16(At[m][k], Bt[n][k], acc[ai][bj][m][n], 0, 0, 0) \
                                      : __builtin_amdgcn_mfma_f32_16x16x32_bf16(Bt[n][k], At[m][k], acc[ai][bj][m][n], 0, 0, 0); } while (0)
#define PG8_WAIT_V(n) asm volatile("s_waitcnt vmcnt(" #n ")" ::: "memory")
#define PG8_WAIT_L(n) asm volatile("s_waitcnt lgkmcnt(" #n ")" ::: "memory")
#define PG8_BAR __builtin_amdgcn_s_barrier()
#define PG8_SCHED __builtin_amdgcn_sched_barrier(0)
    Unit cur, nxt; int ui = 0;
    if (!S.next(0, cur)) return;
    f32x4 acc[2][2][4][2];
#pragma unroll
    for (int a = 0; a < 2; ++a)
#pragma unroll
        for (int b = 0; b < 2; ++b)
#pragma unroll
            for (int m = 0; m < 4; ++m)
#pragma unroll
                for (int n = 0; n < 2; ++n) acc[a][b][m][n] = (f32x4){0.f, 0.f, 0.f, 0.f};
    bf16x8 At[4][2], B0[2][2], B1[2][2];
    const char* cA = (const char*)g.A + (size_t)cur.pm * tstep; const char* cB = (const char*)g.Bt + (size_t)cur.pn * tstep;
    PG8_STAGE(PG8_SB(0, 0), cB, voffB); PG8_STAGE(PG8_SB(0, 1), cB + hstep, voffB); PG8_STAGE(PG8_SA(0, 0), cA, voffA); PG8_STAGE(PG8_SA(0, 1), cA + hstep, voffA);
    if (wr == 1) PG8_BAR;
    PG8_WAIT_V(2); PG8_BAR;
    PG8_STAGE(PG8_SB(1, 0), cB + kstep, voffB); PG8_STAGE(PG8_SA(1, 0), cA + kstep, voffA); PG8_STAGE(PG8_SB(1, 1), cB + hstep + kstep, voffB);
    PG8_WAIT_V(6); PG8_BAR;
    for (;;) {
        const bool has_next = S.next(ui + 1, nxt);
        const char* nA = has_next ? (const char*)g.A + (size_t)nxt.pm * tstep : cA; const char* nB = has_next ? (const char*)g.Bt + (size_t)nxt.pn * tstep : cB;
        for (int t = 0; t < nt; t += 2) {
            const bool last = (t == nt - 2);
            const char* a1 = cA + (size_t)(t + 1) * kstep;
            const char* a2 = last ? nA : cA + (size_t)(t + 2) * kstep; const char* b2 = last ? nB : cB + (size_t)(t + 2) * kstep;
            const char* a3 = a2 + kstep; const char* b3 = b2 + kstep;
            PG8_LDB(B0, 0, 0); PG8_LDB(B1, 0, 1); PG8_SCHED; PG8_LDA(At, 0, 0); PG8_STAGE(PG8_SA(1, 1), a1 + hstep, voffA);
            PG8_WAIT_V(8); PG8_WAIT_L(0); PG8_BAR; __builtin_amdgcn_s_setprio(1); PG8_MMA(0, 0, At, B0); PG8_MMA(0, 1, At, B1); __builtin_amdgcn_s_setprio(0); PG8_BAR; PG8_SCHED;
            PG8_LDA(At, 0, 1); PG8_STAGE(PG8_SB(0, 0), b2, voffB); PG8_STAGE(PG8_SB(0, 1), b2 + hstep, voffB); PG8_STAGE(PG8_SA(0, 0), a2, voffA);
            PG8_WAIT_V(8); PG8_WAIT_L(0); PG8_BAR; __builtin_amdgcn_s_setprio(1); PG8_MMA(1, 0, At, B0); PG8_MMA(1, 1, At, B1); __builtin_amdgcn_s_setprio(0); PG8_BAR; PG8_SCHED;
            PG8_LDB(B0, 1, 0); PG8_LDB(B1, 1, 1); PG8_SCHED; PG8_LDA(At, 1, 0); PG8_STAGE(PG8_SA(0, 1), a2 + hstep, voffA);
            PG8_WAIT_V(8); PG8_WAIT_L(0); PG8_BAR; __builtin_amdgcn_s_setprio(1); PG8_MMA(0, 0, At, B0); PG8_MMA(0, 1, At, B1); __builtin_amdgcn_s_setprio(0); PG8_BAR; PG8_SCHED;
            PG8_LDA(At, 1, 1); PG8_STAGE(PG8_SB(1, 0), b3, voffB); PG8_STAGE(PG8_SB(1, 1), b3 + hstep, voffB); PG8_STAGE(PG8_SA(1, 0), a3, voffA);
            PG8_WAIT_V(8); PG8_WAIT_L(0); PG8_BAR; __builtin_amdgcn_s_setprio(1); PG8_MMA(1, 0, At, B0); PG8_MMA(1, 1, At, B1); __builtin_amdgcn_s_setprio(0); PG8_BAR; PG8_SCHED;
        }
        if (wr == 0) PG8_BAR;
        E(acc, cur, wr, wc, fr, fq);
        if (!has_next) break;
#pragma unroll
        for (int a = 0; a < 2; ++a)
#pragma unroll
            for (int b = 0; b < 2; ++b)
#pragma unroll
                for (int m = 0; m < 4; ++m)
#pragma unroll
                    for (int n = 0; n < 2; ++n) acc[a][b][m][n] = (f32x4){0.f, 0.f, 0.f, 0.f};
        cur = nxt; cA = nA; cB = nB; ++ui;
        if (wr == 1) PG8_BAR;
    }
    PG8_WAIT_V(0);
    PG8_BAR;
#undef PG8_SA
#undef PG8_SB
#undef PG8_STAGE
#undef PG8_LDA
#undef PG8_LDB
#undef PG8_MMA
#undef PG8_WAIT_V
#undef PG8_WAIT_L
#undef PG8_BAR
#undef PG8_SCHED
}
}
using pg8::Unit;

template <bool DRY> struct EpiUZ {
    static constexpr size_t mask = DRY ? DRY_MASK : ~(size_t)0;
    static constexpr bool PERM = true, SWAP = false;
    bf16_t* UZ; const float* rstd;
    __device__ __forceinline__ void operator()(f32x4 (&acc)[2][2][4][2], const Unit& u, int wr, int wc, int fr, int fq) const {
        const int row0 = u.pm * 256 + wr * 64 + fr, col0 = u.pn * 128 + wc * 32 + 8 * fq;
        float rsv[8];
#pragma unroll
        for (int i = 0; i < 8; ++i) rsv[i] = rstd[row0 + (i >> 2) * 128 + (i & 3) * 16];
#pragma unroll
        for (int i = 0; i < 8; ++i) pin(rsv[i]);
#pragma unroll
        for (int ai = 0; ai < 2; ++ai)
#pragma unroll
            for (int m = 0; m < 4; ++m) {
                const int row = row0 + ai * 128 + m * 16; const float rs = rsv[ai * 4 + m];
                unsigned o[4];
#pragma unroll
                for (int n = 0; n < 2; ++n) {
                    const f32x4 uu = acc[ai][0][m][n] * rs, zz = acc[ai][1][m][n] * rs;
                    const float y0 = gelu_silu(uu[0], zz[0]), y1 = gelu_silu(uu[1], zz[1]), y2 = gelu_silu(uu[2], zz[2]), y3 = gelu_silu(uu[3], zz[3]);
                    o[2 * n] = cvt_pk_bf16(y0, y1); o[2 * n + 1] = cvt_pk_bf16(y2, y3);
                }
                *(u32x4*)(UZ + (((size_t)row * EW + col0) & mask)) = (u32x4){o[0], o[1], o[2], o[3]};
            }
    }
};
template <bool DRY> struct EpiGV {
    static constexpr size_t mask = DRY ? DRY_MASK : ~(size_t)0;
    static constexpr bool PERM = false, SWAP = true;
    bf16_t* GVT; const float* rstd; float* lnsum; float* lnsq;
    __device__ __forceinline__ void operator()(f32x4 (&acc)[2][2][4][2], const Unit& u, int wr, int wc, int fr, int fq) const {
        const int ch0 = u.pn * 256 + wc * 32 + fr;
        f32x4 rsv[8];
#pragma unroll
        for (int i = 0; i < 8; ++i) rsv[i] = *(const f32x4*)(rstd + u.pm * 256 + (i >> 2) * 128 + wr * 64 + (i & 3) * 16 + 4 * fq);
#pragma unroll
        for (int i = 0; i < 8; ++i) pin4(rsv[i]);
#pragma unroll
        for (int ai = 0; ai < 2; ++ai)
#pragma unroll
            for (int m = 0; m < 4; ++m) {
                const int t0 = wr * 64 + m * 16 + 4 * fq, tok = u.pm * 256 + ai * 128 + t0, cidx = u.pm * 2 + ai;
                const f32x4 rs = rsv[ai * 4 + m];
                f32x4 s1 = {0.f, 0.f, 0.f, 0.f}, s2 = {0.f, 0.f, 0.f, 0.f};
#pragma unroll
                for (int bj = 0; bj < 2; ++bj)
#pragma unroll
                    for (int n = 0; n < 2; ++n) {
                        const f32x4 v = acc[ai][bj][m][n] * rs;
                        f32x4 gq; gq[0] = gelu_t(v[0]); gq[1] = gelu_t(v[1]); gq[2] = gelu_t(v[2]); gq[3] = gelu_t(v[3]);
                        const unsigned p0 = cvt_pk_bf16(gq[0], gq[1]), p1 = cvt_pk_bf16(gq[2], gq[3]);
                        f32x4 gr; gr[0] = __uint_as_float(p0 << 16); gr[1] = __uint_as_float(p0 & 0xffff0000u); gr[2] = __uint_as_float(p1 << 16); gr[3] = __uint_as_float(p1 & 0xffff0000u);
                        s1 += gr; s2 += gr * gr;
                        const int ch = ch0 + bj * 128 + n * 16;
                        *(u32x2*)(GVT + ((((size_t)cidx * EW + ch) * 128 + t0) & mask)) = (u32x2){p0, p1};
                    }
                float val = 0.f;
#pragma unroll
                for (int j = 0; j < 4; ++j) {
                    const float a = row16_sum(s1[j]), b = row16_sum(s2[j]);
                    val = (fr == 2 * j) ? a : val; val = (fr == 2 * j + 1) ? b : val;
                }
                if (fr < 8) atomicAdd(lnsum + (size_t)(fr & 1) * MT + ((size_t)(tok + (fr >> 1)) & mask), val);
            }
    }
};
template <bool DRY> struct EpiH1 {
    static constexpr size_t mask = DRY ? DRY_MASK : ~(size_t)0;
    static constexpr bool PERM = true, SWAP = false;
    const float* x; float* out; bf16_t* HB; float* rss;
    __device__ __forceinline__ void operator()(f32x4 (&acc)[2][2][4][2], const Unit& u, int wr, int wc, int fr, int fq) const {
        const int row0 = u.pm * 256 + wr * 64 + fr, col0 = u.pn * 256 + wc * 32 + 8 * fq;
#pragma unroll
        for (int ai = 0; ai < 2; ++ai)
#pragma unroll
            for (int m = 0; m < 4; ++m)
#pragma unroll
                for (int bj = 0; bj < 2; ++bj) {
                    const size_t off = (size_t)(row0 + ai * 128 + m * 16) * DM + col0 + bj * 128;
                    acc[ai][bj][m][0] += *(const f32x4*)(x + off); acc[ai][bj][m][1] += *(const f32x4*)(x + off + 4);
                }
#pragma unroll
        for (int ai = 0; ai < 2; ++ai)
#pragma unroll
            for (int bj = 0; bj < 2; ++bj)
#pragma unroll
                for (int m = 0; m < 4; ++m) { pin4(acc[ai][bj][m][0]); pin4(acc[ai][bj][m][1]); }
#pragma unroll
        for (int ai = 0; ai < 2; ++ai)
#pragma unroll
            for (int m = 0; m < 4; ++m) {
                const int row = row0 + ai * 128 + m * 16; float ss = 0.f;
#pragma unroll
                for (int bj = 0; bj < 2; ++bj) {
                    const size_t off = (size_t)row * DM + col0 + bj * 128;
                    const f32x4 h0 = acc[ai][bj][m][0], h1 = acc[ai][bj][m][1];
                    *(u32x4*)(HB + (off & mask)) = (u32x4){cvt_pk_bf16(h0[0], h0[1]), cvt_pk_bf16(h0[2], h0[3]), cvt_pk_bf16(h1[0], h1[1]), cvt_pk_bf16(h1[2], h1[3])};
                    ss += h0[0] * h0[0] + h0[1] * h0[1] + h0[2] * h0[2] + h0[3] * h0[3] + h1[0] * h1[0] + h1[1] * h1[1] + h1[2] * h1[2] + h1[3] * h1[3];
                }
                ss += __shfl_xor(ss, 16); ss += __shfl_xor(ss, 32);
                if (fq == 0) atomicAdd(rss + ((size_t)row & mask), ss);
            }
    }
};
#ifndef PROBE_NOEPI
#define PROBE_NOEPI 0
#endif
__device__ __forceinline__ float acc_sum(const f32x4 (&acc)[2][2][4][2]) { float t = 0.f;
#pragma unroll
    for (int a = 0; a < 2; ++a)
#pragma unroll
        for (int b = 0; b < 2; ++b)
#pragma unroll
            for (int m = 0; m < 4; ++m)
#pragma unroll
                for (int n = 0; n < 2; ++n) t += acc[a][b][m][n][0] + acc[a][b][m][n][1] + acc[a][b][m][n][2] + acc[a][b][m][n][3];
    return t; }
template <bool DRY> struct EpiKQ {
    static constexpr size_t mask = DRY ? DRY_MASK : ~(size_t)0;
    static constexpr bool PERM = true, SWAP = false;
    bf16_t* KT; bf16_t* Q; bf16_t* Zb; const float* rss;
    __device__ __forceinline__ void operator()(f32x4 (&acc)[2][2][4][2], const Unit& u, int wr, int wc, int fr, int fq) const {
        if (DRY && PROBE_NOEPI) { const float t = acc_sum(acc); if (t == 1.2345e30f) KT[0] = 1; return; }
        const int row0 = u.pm * 256 + wr * 64 + fr;
        const bool isK = u.pn < 8;
        float rsv[8];
#pragma unroll
        for (int i = 0; i < 8; ++i) rsv[i] = rss[row0 + (i >> 2) * 128 + (i & 3) * 16];
#pragma unroll
        for (int i = 0; i < 8; ++i) pin(rsv[i]);
#pragma unroll
        for (int ai = 0; ai < 2; ++ai)
#pragma unroll
            for (int m = 0; m < 4; ++m) {
                const int row = row0 + ai * 128 + m * 16; const float rs = __builtin_amdgcn_rsqf(rsv[ai * 4 + m] * (1.0f / DM) + EPS);
#pragma unroll
                for (int bj = 0; bj < 2; ++bj) {
                    f32x4 v0 = acc[ai][bj][m][0] * rs, v1 = acc[ai][bj][m][1] * rs;
                    if (u.pn >= 16) {
#pragma unroll
                        for (int j = 0; j < 4; ++j) { v0[j] = silu_f(v0[j]); v1[j] = silu_f(v1[j]); }
                    }
                    const u32x4 pk = (u32x4){cvt_pk_bf16(v0[0], v0[1]), cvt_pk_bf16(v0[2], v0[3]), cvt_pk_bf16(v1[0], v1[1]), cvt_pk_bf16(v1[2], v1[3])};
                    if (u.pn >= 16) {
                        *(u32x4*)(Zb + (((size_t)row * EW + (u.pn - 16) * 256 + bj * 128 + wc * 32 + 8 * fq) & mask)) = pk;
                    } else if (isK) {
                        const int b = u.pm >> 3, kt = (u.pm & 7) * 4 + ai * 2 + wr, ks = m >> 1, r = (m & 1) * 16 + fr, c = 4 * wc + fq, bh = b * 8 + u.pn;
                        const size_t off = ((((((size_t)bh * 32 + kt) * 2 + bj) * 2 + ks) * 16 + c) * 32 + r) * 8;
                        *(u32x4*)(KT + (off & mask)) = pk;
                    } else {
                        *(u32x4*)(Q + (((size_t)row * EW + (u.pn - 8) * 256 + bj * 128 + wc * 32 + 8 * fq) & mask)) = pk;
                    }
                }
            }
    }
};
template <bool DRY> struct EpiVT {
    static constexpr size_t mask = DRY ? DRY_MASK : ~(size_t)0;
    static constexpr bool PERM = false, SWAP = true;
    bf16_t* VT; const float* rss;
    __device__ __forceinline__ void operator()(f32x4 (&acc)[2][2][4][2], const Unit& u, int wr, int wc, int fr, int fq) const {
        if (DRY && PROBE_NOEPI) { const float t = acc_sum(acc); if (t == 1.2345e30f) VT[0] = 1; return; }
        const int bh = (u.pm >> 3) * 8 + u.pn;
        f32x4 rsv[8];
#pragma unroll
        for (int i = 0; i < 8; ++i) rsv[i] = *(const f32x4*)(rss + u.pm * 256 + (i >> 2) * 128 + wr * 64 + (i & 3) * 16 + 4 * fq);
#pragma unroll
        for (int i = 0; i < 8; ++i) pin4(rsv[i]);
#pragma unroll
        for (int ai = 0; ai < 2; ++ai)
#pragma unroll
            for (int m = 0; m < 4; ++m) {
                const f32x4 q = rsv[ai * 4 + m];
                f32x4 rs; rs[0] = __builtin_amdgcn_rsqf(q[0] * (1.0f / DM) + EPS); rs[1] = __builtin_amdgcn_rsqf(q[1] * (1.0f / DM) + EPS); rs[2] = __builtin_amdgcn_rsqf(q[2] * (1.0f / DM) + EPS); rs[3] = __builtin_amdgcn_rsqf(q[3] * (1.0f / DM) + EPS);
                const int kt = (u.pm & 7) * 4 + ai * 2 + wr;
#pragma unroll
                for (int bj = 0; bj < 2; ++bj)
#pragma unroll
                    for (int n = 0; n < 2; ++n) {
                        const f32x4 v = acc[ai][bj][m][n] * rs;
                        const int et = bj * 4 + wc, r = n * 16 + fr;
                        const size_t off = ((size_t)bh * 32 + kt) * 16384 + (size_t)(((et * 4 + m) * 32 + r) * 16 + 8 * ((fq & 1) ^ ((r >> 3) & 1)) + 4 * (fq >> 1));
                        *(u32x2*)(VT + (off & mask)) = (u32x2){cvt_pk_bf16(v[0], v[1]), cvt_pk_bf16(v[2], v[3])};
                    }
            }
    }
};
template <bool DRY> struct EpiZ {
    static constexpr size_t mask = DRY ? DRY_MASK : ~(size_t)0;
    static constexpr bool PERM = true, SWAP = false;
    const bf16_t* O; bf16_t* Ost; const float* rss;
    __device__ __forceinline__ void operator()(f32x4 (&acc)[2][2][4][2], const Unit& u, int wr, int wc, int fr, int fq) const {
        const int row0 = u.pm * 256 + wr * 64 + fr, col0 = u.pn * 256 + wc * 32 + 8 * fq;
        float rsv[8]; u32x4 ovv[2][4][2];
#pragma unroll
        for (int i = 0; i < 8; ++i) rsv[i] = rss[row0 + (i >> 2) * 128 + (i & 3) * 16];
#pragma unroll
        for (int ai = 0; ai < 2; ++ai)
#pragma unroll
            for (int m = 0; m < 4; ++m)
#pragma unroll
                for (int bj = 0; bj < 2; ++bj) ovv[ai][m][bj] = *(const u32x4*)(O + (size_t)(row0 + ai * 128 + m * 16) * EW + col0 + bj * 128);
#pragma unroll
        for (int i = 0; i < 8; ++i) pin(rsv[i]);
#pragma unroll
        for (int ai = 0; ai < 2; ++ai)
#pragma unroll
            for (int m = 0; m < 4; ++m) { pinu4(ovv[ai][m][0]); pinu4(ovv[ai][m][1]); }
#pragma unroll
        for (int ai = 0; ai < 2; ++ai)
#pragma unroll
            for (int m = 0; m < 4; ++m) {
                const int row = row0 + ai * 128 + m * 16; const float rs = __builtin_amdgcn_rsqf(rsv[ai * 4 + m] * (1.0f / DM) + EPS);
#pragma unroll
                for (int bj = 0; bj < 2; ++bj) {
                    const size_t off = (size_t)row * EW + col0 + bj * 128;
                    const u32x4 ov = ovv[ai][m][bj];
                    const f32x4 z0 = acc[ai][bj][m][0] * rs, z1 = acc[ai][bj][m][1] * rs;
                    u32x4 pk;
                    pk[0] = cvt_pk_bf16(__uint_as_float(ov[0] << 16) * silu_f(z0[0]), __uint_as_float(ov[0] & 0xffff0000u) * silu_f(z0[1]));
                    pk[1] = cvt_pk_bf16(__uint_as_float(ov[1] << 16) * silu_f(z0[2]), __uint_as_float(ov[1] & 0xffff0000u) * silu_f(z0[3]));
                    pk[2] = cvt_pk_bf16(__uint_as_float(ov[2] << 16) * silu_f(z1[0]), __uint_as_float(ov[2] & 0xffff0000u) * silu_f(z1[1]));
                    pk[3] = cvt_pk_bf16(__uint_as_float(ov[3] << 16) * silu_f(z1[2]), __uint_as_float(ov[3] & 0xffff0000u) * silu_f(z1[3]));
                    *(u32x4*)(Ost + (off & mask)) = pk;
                }
            }
    }
};
template <bool DRY> struct EpiH2 {
    static constexpr size_t mask = DRY ? DRY_MASK : ~(size_t)0;
    static constexpr bool PERM = true, SWAP = false;
    const bf16_t* hb; bf16_t* h2b; float* rss;
    __device__ __forceinline__ void operator()(f32x4 (&acc)[2][2][4][2], const Unit& u, int wr, int wc, int fr, int fq) const {
        const int row0 = u.pm * 256 + wr * 64 + fr, col0 = u.pn * 256 + wc * 32 + 8 * fq;
#pragma unroll
        for (int ai = 0; ai < 2; ++ai)
#pragma unroll
            for (int m = 0; m < 4; ++m)
#pragma unroll
                for (int bj = 0; bj < 2; ++bj) {
                    const size_t off = (size_t)(row0 + ai * 128 + m * 16) * DM + col0 + bj * 128;
                    const u32x4 hv = *(const u32x4*)(hb + off);
                    acc[ai][bj][m][0] += (f32x4){__uint_as_float(hv[0] << 16), __uint_as_float(hv[0] & 0xffff0000u), __uint_as_float(hv[1] << 16), __uint_as_float(hv[1] & 0xffff0000u)};
                    acc[ai][bj][m][1] += (f32x4){__uint_as_float(hv[2] << 16), __uint_as_float(hv[2] & 0xffff0000u), __uint_as_float(hv[3] << 16), __uint_as_float(hv[3] & 0xffff0000u)};
                }
#pragma unroll
        for (int ai = 0; ai < 2; ++ai)
#pragma unroll
            for (int bj = 0; bj < 2; ++bj)
#pragma unroll
                for (int m = 0; m < 4; ++m) { pin4(acc[ai][bj][m][0]); pin4(acc[ai][bj][m][1]); }
#pragma unroll
        for (int ai = 0; ai < 2; ++ai)
#pragma unroll
            for (int m = 0; m < 4; ++m) {
                const int row = row0 + ai * 128 + m * 16; float ss = 0.f;
#pragma unroll
                for (int bj = 0; bj < 2; ++bj) {
                    const size_t off = (size_t)row * DM + col0 + bj * 128;
                    const f32x4 h0 = acc[ai][bj][m][0], h1 = acc[ai][bj][m][1];
                    const u32x4 pk = (u32x4){cvt_pk_bf16(h0[0], h0[1]), cvt_pk_bf16(h0[2], h0[3]), cvt_pk_bf16(h1[0], h1[1]), cvt_pk_bf16(h1[2], h1[3])};
                    *(u32x4*)(h2b + (off & mask)) = pk;
#pragma unroll
                    for (int j = 0; j < 4; ++j) { const float a0 = __uint_as_float(pk[j] << 16), a1 = __uint_as_float(pk[j] & 0xffff0000u); ss += a0 * a0 + a1 * a1; }
                }
                ss += __shfl_xor(ss, 16); ss += __shfl_xor(ss, 32);
                if (fq == 0) atomicAdd(rss + ((size_t)row & mask), ss);
            }
    }
};

struct Args { const float* in[19]; float* out; unsigned char* ws; int ph_lo, ph_hi, rep, pad; };

__device__ __forceinline__ float wave_sum(float v) {
#pragma unroll
    for (int o = 32; o > 0; o >>= 1) v += __shfl_xor(v, o);
    return v;
}
__device__ __forceinline__ void transpose_tile(LAS float* tile, const float* W, int ldw, int K, int src, bf16_t* Wt, int n0, int k0, const float* gain, float scale) {
    const int tid = threadIdx.x;
    { const int kk = tid >> 4, c4 = tid & 15;
#pragma unroll
      for (int hk = 0; hk < 2; ++hk) { const int k = k0 + kk + 32 * hk; const f32x4 v = *(const f32x4*)(W + (size_t)k * ldw + src + 4 * c4); const float gs = (gain ? gain[k] : 1.0f) * scale;
#pragma unroll
          for (int i = 0; i < 4; ++i) tile[(4 * c4 + i) * 65 + kk + 32 * hk] = v[i] * gs; } }
    __syncthreads();
    { const int nn = tid >> 3, k8 = tid & 7; float f[8];
#pragma unroll
      for (int i = 0; i < 8; ++i) f[i] = tile[nn * 65 + 8 * k8 + i];
      *(u32x4*)(Wt + (size_t)(n0 + nn) * K + k0 + 8 * k8) = (u32x4){cvt_pk_bf16(f[0], f[1]), cvt_pk_bf16(f[2], f[3]), cvt_pk_bf16(f[4], f[5]), cvt_pk_bf16(f[6], f[7])}; }
    __syncthreads();
}

__device__ void p0_prologue(const Args& a, LAS unsigned char* lds) {
    const int tid = threadIdx.x, lane = tid & 63, wave = tid >> 6, G = gridDim.x, bid = blockIdx.x;
    unsigned char* ws = a.ws;
    { f32x4* z = (f32x4*)(ws + WS_LNSUM); const int n4 = MT;
      for (int i = bid * 512 + tid; i < n4; i += G * 512) z[i] = (f32x4){0.f, 0.f, 0.f, 0.f}; }
    if (bid == 0 && wave == 0) {
        const float* lq1 = a.in[10]; const float* lk1 = a.in[11]; const float* lq2 = a.in[12]; const float* lk2 = a.in[13];
        float s1 = lq1[lane] * lk1[lane] + lq1[lane + 64] * lk1[lane + 64], s2 = lq2[lane] * lk2[lane] + lq2[lane + 64] * lk2[lane + 64];
        s1 = wave_sum(s1); s2 = wave_sum(s2);
        if (lane == 0) ((float*)(ws + WS_CTL))[0] = __expf(s1) - __expf(s2) + LAM_INIT;
    }
    { const float* x = a.in[0]; bf16_t* XB = (bf16_t*)(ws + WS_XB); float* rstd1 = (float*)(ws + WS_RSTD1);
      const int stride = G * 8; int row = bid * 8 + wave; f32x4 v[4], vn[4];
      if (row < MT) {
#pragma unroll
          for (int i = 0; i < 2; ++i) { v[2 * i] = *(const f32x4*)(x + (size_t)row * DM + i * 512 + lane * 8); v[2 * i + 1] = *(const f32x4*)(x + (size_t)row * DM + i * 512 + lane * 8 + 4); } }
      for (; row < MT; row += stride) {
          const int nr = row + stride;
          if (nr < MT) {
#pragma unroll
              for (int i = 0; i < 2; ++i) { vn[2 * i] = *(const f32x4*)(x + (size_t)nr * DM + i * 512 + lane * 8); vn[2 * i + 1] = *(const f32x4*)(x + (size_t)nr * DM + i * 512 + lane * 8 + 4); } }
          float ss = 0.f;
#pragma unroll
          for (int i = 0; i < 4; ++i) ss += v[i][0] * v[i][0] + v[i][1] * v[i][1] + v[i][2] * v[i][2] + v[i][3] * v[i][3];
          ss = wave_sum(ss);
#pragma unroll
          for (int i = 0; i < 2; ++i)
              *(u32x4*)(XB + (size_t)row * DM + i * 512 + lane * 8) = (u32x4){cvt_pk_bf16(v[2 * i][0], v[2 * i][1]), cvt_pk_bf16(v[2 * i][2], v[2 * i][3]), cvt_pk_bf16(v[2 * i + 1][0], v[2 * i + 1][1]), cvt_pk_bf16(v[2 * i + 1][2], v[2 * i + 1][3])};
          if (lane == 0) rstd1[row] = __builtin_amdgcn_rsqf(ss * (1.0f / DM) + EPS);
#pragma unroll
          for (int i = 0; i < 4; ++i) v[i] = vn[i];
      } }
    { const float* wsp = a.in[5]; bf16_t* WSB = (bf16_t*)(ws + WS_WSB); float* r0 = (float*)(ws + WS_R0);
      for (int row = bid * 8 + wave; row < 16 * 128; row += G * 8) {
          const int t = row & 127; float s = 0.f;
#pragma unroll
          for (int i = 0; i < 2; ++i) { const int sc = lane + 64 * i; float v = (sc <= t) ? wsp[(size_t)row * 128 + sc] : 0.f; const unsigned p = cvt_pk_bf16(v, 0.f); WSB[(size_t)row * 128 + sc] = (bf16_t)(p & 0xffffu); s += __uint_as_float(p << 16); }
          s = wave_sum(s);
          if (lane == 0) r0[row] = s;
      } }
    { LAS float* tile = (LAS float*)lds;
      for (int T = bid; T < 4608; T += G) {
          const float* W; int ldw, K, src, n0, k0; bf16_t* Wt; const float* gain = nullptr; float scale = 1.0f;
          if (T < 1536) { K = 1024; const int nt_ = T >> 4; n0 = nt_ * 64; k0 = (T & 15) * 64; W = a.in[2]; ldw = 6144; Wt = (bf16_t*)(ws + WS_WINT); gain = a.in[1];
              if (n0 < 4096) { const int j = n0 >> 8, w = n0 & 255; src = (w < 128) ? 128 * j + w : 4096 + 128 * j + (w - 128); } else src = 2048 + (n0 - 4096); }
          else if (T < 2048) { const int t2 = T - 1536; K = 2048; n0 = (t2 >> 5) * 64; k0 = (t2 & 31) * 64; W = a.in[7]; ldw = 1024; Wt = (bf16_t*)(ws + WS_WOUTT); src = n0; }
          else if (T < 4096) { const int t2 = T - 2048; K = 1024; n0 = (t2 >> 4) * 64; k0 = (t2 & 15) * 64; Wt = (bf16_t*)(ws + WS_WBT); ldw = 4096;
              if (n0 < 2048) { W = a.in[17]; src = n0; gain = a.in[16]; }
              else if (n0 < 4096) { W = a.in[9]; src = n0 - 2048; gain = a.in[8]; scale = QSCALE; }
              else if (n0 < 6144) { W = a.in[9]; src = 2048 + (n0 - 4096); gain = a.in[8]; }
              else { W = a.in[17]; src = 2048 + (n0 - 6144); gain = a.in[16]; } }
          else { const int t2 = T - 4096; K = 2048; n0 = (t2 >> 5) * 64; k0 = (t2 & 31) * 64; W = a.in[15]; ldw = 1024; Wt = (bf16_t*)(ws + WS_WOT); src = n0; }
          transpose_tile(tile, W, ldw, K, src, Wt, n0, k0, gain, scale);
      } }
}

template <bool dry> __device__ void p2_spatial(const Args& a, LAS unsigned char* lds) {
    const int tid = threadIdx.x, wid = __builtin_amdgcn_readfirstlane(tid >> 6), lane = tid & 63, wr = wid >> 2, wc = wid & 3, fr = lane & 15, fq = lane >> 4;
    unsigned char* ws = a.ws;
    const bf16_t* GVT = (const bf16_t*)(ws + WS_GVT); bf16_t* UZ = (bf16_t*)(ws + WS_UZ); const bf16_t* WSB = (const bf16_t*)(ws + WS_WSB);
    const float* lnsum = (const float*)(ws + WS_LNSUM); const float* lnsq = (const float*)(ws + WS_LNSQ); const float* r0g = (const float*)(ws + WS_R0);
    const float* lng = a.in[3]; const float* lnb = a.in[4]; const float* bsg = a.in[6];
    LAS float* smu = (LAS float*)(lds + MISC_OFF); LAS float* srs = smu + 128; LAS float* sr1 = smu + 256;
    int Rr[2], Cc[2];
#pragma unroll
    for (int i = 0; i < 2; ++i) pg8::stage_rc(tid * 16 + i * 8192, Rr[i], Cc[i]);
    const int aoff = pg8::lds_byte(wr * 64 + fr, fq * 8), boff = pg8::lds_byte(wc * 32 + fr, fq * 8);
    for (int it = blockIdx.x; it < 512 * 16; it += gridDim.x) {
        const int cidx = it >> 4, g = it & 15;
        if (tid < 128) { const int tok = cidx * 128 + tid; const float mu = lnsum[tok] * (1.0f / EW); const float var = lnsq[tok] * (1.0f / EW) - mu * mu;
            smu[tid] = mu; srs[tid] = __builtin_amdgcn_rsqf(fmaxf(var, 0.f) + EPS); sr1[tid] = 0.f; }
        const bf16_t* Bt = GVT + ((size_t)cidx * EW + g * 128) * 128;
#pragma unroll
        for (int kh = 0; kh < 2; ++kh)
#pragma unroll
            for (int i = 0; i < 2; ++i) { const int Rb = (Rr[i] & ~31) + pg8::perm32(Rr[i] & 31);
                __builtin_amdgcn_global_load_lds((const unsigned*)(Bt + (size_t)Rb * 128 + kh * 64 + Cc[i]), (LAS unsigned*)(lds + 32768 + kh * 16384 + wid * 1024 + i * 8192), 16, 0, 0); }
        __syncthreads();
        const bf16_t* Aw = WSB + (size_t)g * 16384;
#pragma unroll
        for (int kh = 0; kh < 2; ++kh)
#pragma unroll
            for (int i = 0; i < 2; ++i) {
                const int R = Rr[i], C = kh * 64 + Cc[i];
                const u32x4 wv = *(const u32x4*)(Aw + (size_t)R * 128 + C);
                float f[8]; float part = 0.f;
#pragma unroll
                for (int j = 0; j < 4; ++j) { f[2 * j] = __uint_as_float(wv[j] << 16) * srs[C + 2 * j]; f[2 * j + 1] = __uint_as_float(wv[j] & 0xffff0000u) * srs[C + 2 * j + 1]; }
                u32x4 pk;
#pragma unroll
                for (int j = 0; j < 4; ++j) { pk[j] = cvt_pk_bf16(f[2 * j], f[2 * j + 1]); part += __uint_as_float(pk[j] << 16) * smu[C + 2 * j] + __uint_as_float(pk[j] & 0xffff0000u) * smu[C + 2 * j + 1]; }
                *(LAS u32x4*)(lds + kh * 16384 + tid * 16 + i * 8192) = pk;
                atomicAdd((float*)(sr1 + R), part);
            }
        asm volatile("s_waitcnt vmcnt(0)" ::: "memory");
        __syncthreads();
        f32x4 acc[4][2];
#pragma unroll
        for (int m = 0; m < 4; ++m)
#pragma unroll
            for (int n = 0; n < 2; ++n) acc[m][n] = (f32x4){0.f, 0.f, 0.f, 0.f};
#pragma unroll
        for (int kh = 0; kh < 2; ++kh)
#pragma unroll
            for (int k = 0; k < 2; ++k) {
                bf16x8 Af[4], Bf[2];
#pragma unroll
                for (int m = 0; m < 4; ++m) Af[m] = *(const LAS bf16x8*)(lds + kh * 16384 + aoff + m * 2048 + k * 1024);
#pragma unroll
                for (int n = 0; n < 2; ++n) Bf[n] = *(const LAS bf16x8*)(lds + 32768 + kh * 16384 + boff + n * 2048 + k * 1024);
#pragma unroll
                for (int m = 0; m < 4; ++m)
#pragma unroll
                    for (int n = 0; n < 2; ++n) acc[m][n] = __builtin_amdgcn_mfma_f32_16x16x32_bf16(Bf[n], Af[m], acc[m][n], 0, 0, 0);
            }
        const int c0 = wc * 32 + 8 * fq, cg0 = g * 128 + c0;
        const f32x4 g0 = *(const f32x4*)(lng + cg0), g1 = *(const f32x4*)(lng + cg0 + 4), b0 = *(const f32x4*)(lnb + cg0), b1 = *(const f32x4*)(lnb + cg0 + 4);
        u32x4 uvv[4]; float r0v[4], bsv[4];
#pragma unroll
        for (int m = 0; m < 4; ++m) { const int t = wr * 64 + m * 16 + fr; uvv[m] = *(const u32x4*)(UZ + ((size_t)cidx * 128 + t) * EW + cg0); r0v[m] = r0g[g * 128 + t]; bsv[m] = bsg[g * 128 + t]; }
#pragma unroll
        for (int m = 0; m < 4; ++m) { pinu4(uvv[m]); pin(r0v[m]); pin(bsv[m]); }
#pragma unroll
        for (int m = 0; m < 4; ++m) {
            const int t = wr * 64 + m * 16 + fr; const float r1 = sr1[t], r0 = r0v[m], bs = bsv[m];
            bf16_t* p = UZ + ((size_t)cidx * 128 + t) * EW + cg0;
            const u32x4 uv = uvv[m];
            const f32x4 s0 = g0 * (acc[m][0] - r1) + b0 * r0 + bs, s1 = g1 * (acc[m][1] - r1) + b1 * r0 + bs;
            u32x4 pk;
            pk[0] = cvt_pk_bf16(__uint_as_float(uv[0] << 16) * s0[0], __uint_as_float(uv[0] & 0xffff0000u) * s0[1]);
            pk[1] = cvt_pk_bf16(__uint_as_float(uv[1] << 16) * s0[2], __uint_as_float(uv[1] & 0xffff0000u) * s0[3]);
            pk[2] = cvt_pk_bf16(__uint_as_float(uv[2] << 16) * s1[0], __uint_as_float(uv[2] & 0xffff0000u) * s1[1]);
            pk[3] = cvt_pk_bf16(__uint_as_float(uv[3] << 16) * s1[2], __uint_as_float(uv[3] & 0xffff0000u) * s1[3]);
            *(u32x4*)(dry ? (bf16_t*)(ws + WS_DUMMY) + (((size_t)t * EW + cg0) & DRY_MASK) : p) = pk;
        }
        __syncthreads();
    }
}

__device__ __forceinline__ float max3f(float a, float b, float c) { float r; asm("v_max3_f32 %0, %1, %2, %3" : "=v"(r) : "v"(a), "v"(b), "v"(c)); return r; }
__device__ __forceinline__ float xhalf_max(float v) {
    const unsigned u = __float_as_uint(v);
    const auto sw = __builtin_amdgcn_permlane32_swap(u, u, false, false);
    const float a_ = __uint_as_float(sw[0]), b_ = __uint_as_float(sw[1]); return max3f(a_, b_, b_);
}
#ifndef PROBE_NOCOMP
#define PROBE_NOCOMP 0
#endif
#define DS_RD(dst, addr, off) asm volatile("ds_read_b128 %0, %1 offset:%2" : "=v"(dst) : "v"(addr), "n"(off))
#define LGKM(N, dst) do { asm volatile("s_waitcnt lgkmcnt(%0)" :: "n"(N) : "memory"); __builtin_amdgcn_sched_barrier(0); } while (0)
template <bool dry> __device__ void p5_attention(const Args& a, LAS unsigned char* lds) {
    const unsigned ldsb = (unsigned)(uintptr_t)lds;
    const int tid = threadIdx.x, w = __builtin_amdgcn_readfirstlane(tid >> 6), lane = tid & 63, rg = w & 3, n = w >> 2, r = lane & 31, hh = lane >> 5;
    unsigned char* ws = a.ws;
    const bf16_t* KT = (const bf16_t*)(ws + WS_UZ); const bf16_t* VT = (const bf16_t*)(ws + WS_GVT); bf16_t* QO = (bf16_t*)(ws + WS_Q);
    const float* subg = a.in[14];
    const float lam = ((const float*)(ws + WS_CTL))[0];
    const int G = gridDim.x, v0 = (G == 256) ? ((blockIdx.x & 7) * 32 + (blockIdx.x >> 3)) : blockIdx.x;
    const unsigned dmao = (unsigned)tid * 16u;
    LAS float* sg = (LAS float*)(lds + MISC_OFF);
    if (tid < 256) sg[tid] = subg[tid] * (1.0f - LAM_INIT);
    __syncthreads();
    const int koff = (((n * 2) * 16 + hh) * 32 + r) * 16;
    const int voff = 32768 + r * 32 + 16 * (hh ^ ((r >> 3) & 1));
    for (int p = v0; p < 2048; p += G) {
        const int bh = p >> 3, jj = p & 7, b = bh >> 3, h = bh & 7;
        for (int pass = 0; pass < 2; ++pass) {
            const int qb = pass == 0 ? 15 - jj : jj;
            bf16x8 Qf[8];
            { const int tok = b * SEQ + qb * 128 + rg * 32 + r;
              const bf16_t* qp = QO + (size_t)tok * EW + h * 256;
#pragma unroll
              for (int s = 0; s < 8; ++s) Qf[s] = *(const bf16x8*)(qp + n * 128 + 16 * s + 8 * hh); }
            f32x16 O[8];
#pragma unroll
            for (int e = 0; e < 8; ++e)
#pragma unroll
                for (int i = 0; i < 16; ++i) O[e][i] = 0.f;
            float m_run = -INFINITY, l_run = 0.f;
            const int nkt = 2 * qb + 2;
            const bf16_t* kbase = KT + (size_t)bh * 32 * 16384; const bf16_t* vbase = VT + (size_t)bh * 32 * 16384;
            unsigned dof0 = dmao; asm volatile("" : "+v"(dof0));
#pragma unroll
            for (int i = 0; i < 4; ++i) {
                __builtin_amdgcn_global_load_lds((const unsigned*)((const char*)kbase + i * 8192 + dof0), (LAS unsigned*)(lds + i * 8192 + w * 1024), 16, 0, 0);
                __builtin_amdgcn_global_load_lds((const unsigned*)((const char*)vbase + i * 8192 + dof0), (LAS unsigned*)(lds + 32768 + i * 8192 + w * 1024), 16, 0, 0);
            }
            asm volatile("s_waitcnt vmcnt(0)" ::: "memory");
            __builtin_amdgcn_s_barrier();
            const int q_lo = qb * 128 + rg * 32;
            for (int kt = 0; kt < nkt; ++kt) {
                const int bufo = (kt & 1) * 65536;
                if (kt + 1 < nkt) {
                    const char* kg = (const char*)(kbase + (size_t)(kt + 1) * 16384); const char* vg = (const char*)(vbase + (size_t)(kt + 1) * 16384); const int nb = 65536 - bufo;
                    unsigned dof = dmao; asm volatile("" : "+v"(dof));
#pragma unroll
                    for (int i = 0; i < 4; ++i) {
                        __builtin_amdgcn_global_load_lds((const unsigned*)(kg + i * 8192 + dof), (LAS unsigned*)(lds + nb + i * 8192 + w * 1024), 16, 0, 0);
                        __builtin_amdgcn_global_load_lds((const unsigned*)(vg + i * 8192 + dof), (LAS unsigned*)(lds + nb + 32768 + i * 8192 + w * 1024), 16, 0, 0);
                    }
                }
                const int key0 = kt * 64;
                const bool act0 = key0 <= q_lo + 31;
                if (act0 && !(dry && PROBE_NOCOMP)) {
                    const unsigned kb = ldsb + bufo + koff, vb = ldsb + bufo + voff;
                    u32x4 f0, f1, f2, f3, f4, f5, f6;
                    f32x16 S0, S1;
#pragma unroll
                    for (int i = 0; i < 16; ++i) { S0[i] = 0.f; S1[i] = 0.f; }
#define K_LOAD(F, KS, SI) DS_RD(F, kb, (KS) * 8192 + (SI) * 1024)
#define K_STEP(SV, F, SI, WN) LGKM(WN, F); SV = __builtin_amdgcn_mfma_f32_32x32x16_bf16(__builtin_bit_cast(bf16x8, F), Qf[SI], SV, 0, 0, 0); __builtin_amdgcn_sched_barrier(0)
#define V_LOAD(F, KS, E, S2) DS_RD(F, vb, (KS) * 2048 + (E) * 4096 + (S2) * 1024)
#define V_STEP(PF, F, E, S2, WN, X) LGKM(WN, F); O[E] = __builtin_amdgcn_mfma_f32_32x32x16_bf16(__builtin_bit_cast(bf16x8, F), PF[S2], O[E], 0, 0, 0); X; __builtin_amdgcn_sched_barrier(0)
#define QK_SUB(SV, KS) K_LOAD(f0, KS, 0); \
                    K_LOAD(f1, KS, 1); \
                    K_LOAD(f2, KS, 2); \
                    K_LOAD(f3, KS, 3); \
                    K_LOAD(f4, KS, 4); \
                    K_LOAD(f5, KS, 5); \
                    K_STEP(SV, f0, 0, 5); K_LOAD(f0, KS, 6); \
                    K_STEP(SV, f1, 1, 5); K_LOAD(f1, KS, 7); \
                    K_STEP(SV, f2, 2, 5); \
                    K_STEP(SV, f3, 3, 4); \
                    K_STEP(SV, f4, 4, 3); \
                    K_STEP(SV, f5, 5, 2); \
                    K_STEP(SV, f0, 6, 1); \
                    K_STEP(SV, f1, 7, 0)
#define PV_HEAD(KS) V_LOAD(f0, KS, 0, 0); V_LOAD(f1, KS, 1, 0); V_LOAD(f2, KS, 2, 0); V_LOAD(f3, KS, 3, 0); V_LOAD(f4, KS, 4, 0); V_LOAD(f5, KS, 5, 0); V_LOAD(f6, KS, 6, 0)
#define PV_BODY(PF, KS, X) \
                    V_STEP(PF, f0, 0, 0, 6, X(0)); V_LOAD(f0, KS, 7, 0); \
                    V_STEP(PF, f1, 1, 0, 6, X(1)); V_LOAD(f1, KS, 0, 1); \
                    V_STEP(PF, f2, 2, 0, 6, X(2)); V_LOAD(f2, KS, 1, 1); \
                    V_STEP(PF, f3, 3, 0, 6, X(3)); V_LOAD(f3, KS, 2, 1); \
                    V_STEP(PF, f4, 4, 0, 6, X(4)); V_LOAD(f4, KS, 3, 1); \
                    V_STEP(PF, f5, 5, 0, 6, X(5)); V_LOAD(f5, KS, 4, 1); \
                    V_STEP(PF, f6, 6, 0, 6, X(6)); V_LOAD(f6, KS, 5, 1); \
                    V_STEP(PF, f0, 7, 0, 6, X(7)); V_LOAD(f0, KS, 6, 1); \
                    V_STEP(PF, f1, 0, 1, 6, X(8)); V_LOAD(f1, KS, 7, 1); \
                    V_STEP(PF, f2, 1, 1, 6, X(9)); \
                    V_STEP(PF, f3, 2, 1, 5, X(10)); \
                    V_STEP(PF, f4, 3, 1, 4, X(11)); \
                    V_STEP(PF, f5, 4, 1, 3, X(12)); \
                    V_STEP(PF, f6, 5, 1, 2, X(13)); \
                    V_STEP(PF, f0, 6, 1, 1, X(14)); \
                    V_STEP(PF, f1, 7, 1, 0, X(15))
#define NOP_X(i) (void)0
#define EXP_X(i) S1[i] = __builtin_amdgcn_exp2f(S1[i] - m1)
#define ROWMAX(SV, MT) { const float t0 = max3f(SV[0], SV[1], SV[2]), t1 = max3f(SV[3], SV[4], SV[5]), t2 = max3f(SV[6], SV[7], SV[8]), t3 = max3f(SV[9], SV[10], SV[11]), t4 = max3f(SV[12], SV[13], SV[14]); \
                    MT = xhalf_max(max3f(max3f(t0, t1, t2), max3f(t3, t4, SV[15]), SV[15])); }
#define PACKP(PF, SV) { _Pragma("unroll") for (int s_ = 0; s_ < 2; ++s_) { const int o8 = s_ * 8; \
                    const u32x4 pk_ = (u32x4){cvt_pk_bf16(SV[o8 + 0], SV[o8 + 1]), cvt_pk_bf16(SV[o8 + 2], SV[o8 + 3]), cvt_pk_bf16(SV[o8 + 4], SV[o8 + 5]), cvt_pk_bf16(SV[o8 + 6], SV[o8 + 7])}; PF[s_] = __builtin_bit_cast(bf16x8, pk_); } }
                    __builtin_amdgcn_s_setprio(1);
                    QK_SUB(S0, 0);
                    QK_SUB(S1, 1);
                    __builtin_amdgcn_s_setprio(0);
                    const int qa = q_lo + r;
                    if (key0 + 31 > q_lo) {
#pragma unroll
                        for (int i = 0; i < 16; ++i) { const int ka = key0 + (i & 3) + 8 * (i >> 2) + 4 * hh; if (ka > qa) S0[i] = -INFINITY; }
                    }
                    float mt0; ROWMAX(S0, mt0);
                    const float m0 = (mt0 > m_run + 8.0f) ? mt0 : m_run;
                    if (__any(m0 != m_run)) {
                        const float alpha = __builtin_amdgcn_exp2f(m_run - m0);
                        l_run *= alpha;
#pragma unroll
                        for (int e = 0; e < 8; ++e)
#pragma unroll
                            for (int i = 0; i < 16; ++i) O[e][i] *= alpha;
                    }
                    m_run = m0;
                    PV_HEAD(0);
                    float ls = 0.f;
                    bf16x8 P0[2];
#pragma unroll
                    for (int h8 = 0; h8 < 2; ++h8) {
                        float pe[8];
#pragma unroll
                        for (int i = 0; i < 8; ++i) { pe[i] = __builtin_amdgcn_exp2f(S0[8 * h8 + i] - m0); ls += pe[i]; }
                        const u32x4 pk_ = (u32x4){cvt_pk_bf16(pe[0], pe[1]), cvt_pk_bf16(pe[2], pe[3]), cvt_pk_bf16(pe[4], pe[5]), cvt_pk_bf16(pe[6], pe[7])};
                        P0[h8] = __builtin_bit_cast(bf16x8, pk_);
                        __builtin_amdgcn_sched_barrier(0);
                    }
                    l_run += ls;
                    __builtin_amdgcn_sched_barrier(0);
                    {
                        if (key0 + 63 > q_lo) {
#pragma unroll
                            for (int i = 0; i < 16; ++i) { const int ka = key0 + 32 + (i & 3) + 8 * (i >> 2) + 4 * hh; if (ka > qa) S1[i] = -INFINITY; }
                        }
                        float mt1; ROWMAX(S1, mt1);
                        const float m1 = (mt1 > m0 + 8.0f) ? mt1 : m0;
                        __builtin_amdgcn_sched_barrier(0);
                        __builtin_amdgcn_s_setprio(1);
                        PV_BODY(P0, 0, EXP_X);
                        __builtin_amdgcn_s_setprio(0);
                        if (__any(m1 != m0)) {
                            const float alpha = __builtin_amdgcn_exp2f(m0 - m1);
                            l_run *= alpha;
#pragma unroll
                            for (int e = 0; e < 8; ++e)
#pragma unroll
                                for (int i = 0; i < 16; ++i) O[e][i] *= alpha;
                        }
                        m_run = m1;
                        PV_HEAD(1);
                        float ls1 = 0.f;
#pragma unroll
                        for (int i = 0; i < 16; ++i) ls1 += S1[i];
                        l_run += ls1;
                        bf16x8 P1[2];
                        PACKP(P1, S1);
                        __builtin_amdgcn_sched_barrier(0);
                        __builtin_amdgcn_s_setprio(1);
                        PV_BODY(P1, 1, NOP_X);
                        __builtin_amdgcn_s_setprio(0);
                    }
#undef K_LOAD
#undef K_STEP
#undef V_LOAD
#undef V_STEP
#undef QK_SUB
#undef PV_HEAD
#undef PV_BODY
#undef NOP_X
#undef EXP_X
#undef ROWMAX
#undef PACKP
                }
                asm volatile("s_waitcnt vmcnt(0)" ::: "memory");
                __builtin_amdgcn_s_barrier();
            }
            const float l_tot = l_run + __shfl_xor(l_run, 32);
            if (n == 1) {
                const float sc = lam / l_tot;
#pragma unroll
                for (int e = 0; e < 8; ++e)
#pragma unroll
                    for (int g4 = 0; g4 < 4; ++g4)
                        *(LAS f32x4*)(lds + ((rg * 32 + e * 4 + g4) * 64 + lane) * 16) = (f32x4){O[e][4 * g4] * sc, O[e][4 * g4 + 1] * sc, O[e][4 * g4 + 2] * sc, O[e][4 * g4 + 3] * sc};
            }
            __syncthreads();
            if (n == 0) {
                const int lane2 = __builtin_amdgcn_mbcnt_hi(~0u, __builtin_amdgcn_mbcnt_lo(~0u, 0u)), r2 = lane2 & 31, hh2 = lane2 >> 5;
                const int tok2 = b * SEQ + qb * 128 + rg * 32 + r2;
                const float inv = 1.0f / l_tot; float ss = 0.f;
#pragma unroll
                for (int e = 0; e < 8; ++e)
#pragma unroll
                    for (int g4 = 0; g4 < 4; ++g4) {
                        const f32x4 x2 = *(const LAS f32x4*)(lds + ((rg * 32 + e * 4 + g4) * 64 + lane2) * 16);
#pragma unroll
                        for (int j = 0; j < 4; ++j) { const float o = O[e][4 * g4 + j] * inv - x2[j]; O[e][4 * g4 + j] = o; ss += o * o; }
                    }
                ss += __shfl_xor(ss, 32);
                const float rs = __builtin_amdgcn_rsqf(ss * (1.0f / 256.0f) + EPS);
                bf16_t* qst = QO + (size_t)tok2 * EW + h * 256;
                const bf16_t* zp = (const bf16_t*)a.out + (size_t)tok2 * EW + h * 256;
                u32x2 zv[8][4];
#pragma unroll
                for (int e = 0; e < 8; ++e)
#pragma unroll
                    for (int g4 = 0; g4 < 4; ++g4) zv[e][g4] = *(const u32x2*)(zp + 32 * e + 8 * g4 + 4 * hh2);
#pragma unroll
                for (int e = 0; e < 8; ++e)
#pragma unroll
                    for (int g4 = 0; g4 < 4; ++g4) asm volatile("" : "+v"(zv[e][g4]));
                if (!dry || rs == 1.2345e30f)
#pragma unroll
                for (int e = 0; e < 8; ++e)
#pragma unroll
                    for (int g4 = 0; g4 < 4; ++g4) {
                        const int e0 = 32 * e + 8 * g4 + 4 * hh2;
                        const f32x4 gn = *(const LAS f32x4*)(sg + e0);
                        const u32x2 zz = zv[e][g4];
                        *(u32x2*)(qst + e0) = (u32x2){cvt_pk_bf16(O[e][4 * g4] * rs * gn[0] * __uint_as_float(zz[0] << 16), O[e][4 * g4 + 1] * rs * gn[1] * __uint_as_float(zz[0] & 0xffff0000u)),
                                                      cvt_pk_bf16(O[e][4 * g4 + 2] * rs * gn[2] * __uint_as_float(zz[1] << 16), O[e][4 * g4 + 3] * rs * gn[3] * __uint_as_float(zz[1] & 0xffff0000u))};
                    }
            }
            __syncthreads();
        }
    }
}

template <bool dry> __device__ void p8_final(const Args& a, LAS unsigned char*) {
    const int tid = threadIdx.x, lane = tid & 63, wave = tid >> 6;
    const float* rss3 = (const float*)(a.ws + WS_RSS3); const float* fg = a.in[18]; float* out = a.out; const bf16_t* h2b = (const bf16_t*)(a.ws + WS_UZ);
    f32x4 gq[4];
#pragma unroll
    for (int i = 0; i < 4; ++i) gq[i] = *(const f32x4*)(fg + i * 256 + lane * 4);
    const int stride = gridDim.x * 8; int row = blockIdx.x * 8 + wave;
    u32x2 v[4], vn[4]; float q = 0.f, qn = 0.f;
    if (row < MT) { q = rss3[row];
#pragma unroll
        for (int i = 0; i < 4; ++i) v[i] = *(const u32x2*)(h2b + (size_t)row * DM + i * 256 + lane * 4); }
    for (; row < MT; row += stride) {
        const int nr = row + stride;
        if (nr < MT) { qn = rss3[nr];
#pragma unroll
            for (int i = 0; i < 4; ++i) vn[i] = *(const u32x2*)(h2b + (size_t)nr * DM + i * 256 + lane * 4); }
        const float rs = __builtin_amdgcn_rsqf(q * (1.0f / DM) + EPS);
        float* p = dry ? (float*)(a.ws + WS_DUMMY) + (((size_t)row * DM) & DRY_MASK) : out + (size_t)row * DM;
#pragma unroll
        for (int i = 0; i < 4; ++i) {
            const f32x4 h = (f32x4){__uint_as_float(v[i][0] << 16), __uint_as_float(v[i][0] & 0xffff0000u), __uint_as_float(v[i][1] << 16), __uint_as_float(v[i][1] & 0xffff0000u)};
            *(f32x4*)(p + i * 256 + lane * 4) = h * rs * gq[i];
        }
        q = qn;
#pragma unroll
        for (int i = 0; i < 4; ++i) v[i] = vn[i];
    }
}

#ifndef PROBE_MASK
#define PROBE_MASK 0
#endif
template <bool DRY> __device__ __forceinline__ void ph1(const Args& a, LAS unsigned char* lds) {
    unsigned char* ws = a.ws; unsigned char* dmy = ws + WS_DUMMY; const int G = gridDim.x, bid = blockIdx.x;
    { pg8::Gemm g{(const bf16_t*)(ws + WS_XB), (const bf16_t*)(ws + WS_WINT), MT, 4096, DM}; pg8::StaticOrder S; S.init(MT, 4096, G, bid);
      EpiUZ<DRY> E{DRY ? (bf16_t*)dmy : (bf16_t*)(ws + WS_UZ), (const float*)(ws + WS_RSTD1)}; pg8::gemm_phase<EpiUZ<DRY>>(lds, g, S, E); }
    { pg8::Gemm g{(const bf16_t*)(ws + WS_XB), (const bf16_t*)(ws + WS_WINT) + (size_t)4096 * DM, MT, 2048, DM}; pg8::StaticOrder S; S.init(MT, 2048, G, bid);
      EpiGV<DRY> E{DRY ? (bf16_t*)dmy : (bf16_t*)(ws + WS_GVT), (const float*)(ws + WS_RSTD1), DRY ? (float*)dmy + (1 << 23) : (float*)(ws + WS_LNSUM), DRY ? (float*)dmy + (1 << 23) : (float*)(ws + WS_LNSQ)}; pg8::gemm_phase<EpiGV<DRY>>(lds, g, S, E); }
}
template <bool DRY> __device__ __forceinline__ void ph3(const Args& a, LAS unsigned char* lds) {
    unsigned char* ws = a.ws; unsigned char* dmy = ws + WS_DUMMY; const int G = gridDim.x, bid = blockIdx.x;
    pg8::Gemm g{(const bf16_t*)(ws + WS_UZ), (const bf16_t*)(ws + WS_WOUTT), MT, DM, EW}; pg8::StaticOrder S; S.init(MT, DM, G, bid);
    EpiH1<DRY> E{a.in[0], DRY ? (float*)dmy : a.out, DRY ? (bf16_t*)dmy : (bf16_t*)(ws + WS_XB), DRY ? (float*)dmy + (1 << 23) : (float*)(ws + WS_RSS2)}; pg8::gemm_phase<EpiH1<DRY>>(lds, g, S, E);
}
template <bool DRY> __device__ __forceinline__ void ph4(const Args& a, LAS unsigned char* lds) {
    unsigned char* ws = a.ws; unsigned char* dmy = ws + WS_DUMMY; const int G = gridDim.x, bid = blockIdx.x;
    { pg8::Gemm g{(const bf16_t*)(ws + WS_XB), (const bf16_t*)(ws + WS_WBT), MT, 6144, DM}; pg8::StaticOrder S; S.init(MT, 6144, G, bid);
      EpiKQ<DRY> E{DRY ? (bf16_t*)dmy : (bf16_t*)(ws + WS_UZ), DRY ? (bf16_t*)dmy : (bf16_t*)(ws + WS_Q), DRY ? (bf16_t*)dmy : (bf16_t*)a.out, (const float*)(ws + WS_RSS2)}; pg8::gemm_phase<EpiKQ<DRY>>(lds, g, S, E); }
    { pg8::Gemm g{(const bf16_t*)(ws + WS_XB), (const bf16_t*)(ws + WS_WBT) + (size_t)6144 * DM, MT, 2048, DM}; pg8::StaticOrder S; S.init(MT, 2048, G, bid);
      EpiVT<DRY> E{DRY ? (bf16_t*)dmy : (bf16_t*)(ws + WS_GVT), (const float*)(ws + WS_RSS2)}; pg8::gemm_phase<EpiVT<DRY>>(lds, g, S, E); }
}
template <bool DRY> __device__ __forceinline__ void ph6(const Args& a, LAS unsigned char* lds) {
    unsigned char* ws = a.ws; unsigned char* dmy = ws + WS_DUMMY; const int G = gridDim.x, bid = blockIdx.x;
    pg8::Gemm g{(const bf16_t*)(ws + WS_XB), (const bf16_t*)(ws + WS_WBT) + (size_t)4096 * DM, MT, 2048, DM}; pg8::StaticOrder S; S.init(MT, 2048, G, bid);
    EpiZ<DRY> E{(const bf16_t*)(ws + WS_Q), DRY ? (bf16_t*)dmy : (bf16_t*)(ws + WS_Q), (const float*)(ws + WS_RSS2)}; pg8::gemm_phase<EpiZ<DRY>>(lds, g, S, E);
}
template <bool DRY> __device__ __forceinline__ void ph7(const Args& a, LAS unsigned char* lds) {
    unsigned char* ws = a.ws; unsigned char* dmy = ws + WS_DUMMY; const int G = gridDim.x, bid = blockIdx.x;
    pg8::Gemm g{(const bf16_t*)(ws + WS_Q), (const bf16_t*)(ws + WS_WOT), MT, DM, EW}; pg8::StaticOrder S; S.init(MT, DM, G, bid);
    EpiH2<DRY> E{(const bf16_t*)(ws + WS_XB), DRY ? (bf16_t*)dmy : (bf16_t*)(ws + WS_UZ), DRY ? (float*)dmy + (1 << 23) : (float*)(ws + WS_RSS3)}; pg8::gemm_phase<EpiH2<DRY>>(lds, g, S, E);
}

#define XB_TMO      128
#define XB_XCNT(j)  (256  + 64 * (j))
#define XB_XSUB(j)  (1280 + 64 * (j))
#define XB_XGEN(j)  (2304 + 64 * (j))
#define XB_TOP      3328
#define XB_TOPGEN   3392
#define XCD_BAR_WORDS 3456
#define XB_SPIN_CAP (1u << 18)
__device__ __forceinline__ unsigned xb_ld(unsigned* p)              { return __hip_atomic_load(p, __ATOMIC_RELAXED, __HIP_MEMORY_SCOPE_AGENT); }
__device__ __forceinline__ unsigned xb_add(unsigned* p, unsigned v) { return __hip_atomic_fetch_add(p, v, __ATOMIC_RELAXED, __HIP_MEMORY_SCOPE_AGENT); }
__device__ __forceinline__ unsigned xb_xcc_id() { return (unsigned)__builtin_amdgcn_s_getreg((3 << 11) | 20) & 0xFu; }
#define XB_SPIN(cond, bar) do { unsigned _sp = 0; while (cond) { __builtin_amdgcn_s_sleep(1); \
    if ((++_sp & 255u) == 0u) { if (xb_ld(&(bar)[XB_TMO])) break; if (_sp > XB_SPIN_CAP) { atomicAdd(&(bar)[XB_TMO], 1u); break; } } } } while (0)
struct XcdBarrier { unsigned* bar; unsigned x; volatile LAS unsigned* st; };
__device__ __forceinline__ XcdBarrier xcd_barrier_post(unsigned* bar, volatile LAS unsigned* st) {
    XcdBarrier b; b.bar = bar; b.x = xb_xcc_id(); b.st = st;
    if (threadIdx.x == 0) (void)xb_add(&bar[XB_XCNT(b.x)], 1u);
    return b;
}
__device__ __forceinline__ void xcd_barrier_complete(unsigned* bar, unsigned x, unsigned& nloc, unsigned& nx) {
    const unsigned G = gridDim.x * gridDim.y * gridDim.z;
    unsigned sum, cnt, mine, sp = 0u;
    for (;;) {
        sum = 0u; cnt = 0u; mine = 0u;
#pragma unroll
        for (unsigned j = 0; j < 16; ++j) { const unsigned c = xb_ld(&bar[XB_XCNT(j)]); sum += c; cnt += (c > 0u) ? 1u : 0u; mine = (j == x) ? c : mine; }
        if (sum == G) break;
        __builtin_amdgcn_s_sleep(1);
        if ((++sp & 255u) == 0u) { if (xb_ld(&bar[XB_TMO])) break; if (sp > XB_SPIN_CAP) { atomicAdd(&bar[XB_TMO], 1u); break; } }
    }
    nloc = mine > 0u ? mine : 1u; nx = cnt > 0u ? cnt : 1u;
}
__device__ __forceinline__ void xcd_barrier(const XcdBarrier& b) {
    asm volatile("s_waitcnt vmcnt(0)" ::: "memory");
    __syncthreads();
    if (threadIdx.x == 0) {
        unsigned* bar = b.bar;
        __builtin_amdgcn_s_waitcnt(0);
        unsigned nloc = b.st[0], nx = b.st[1];
        if (nloc == 0u) { xcd_barrier_complete(bar, b.x, nloc, nx); b.st[0] = nloc; b.st[1] = nx; }
        const unsigned old = xb_add(&bar[XB_XSUB(b.x)], 1u);
        const unsigned gen = old / nloc;
        if (old + 1u == (gen + 1u) * nloc) {
            __builtin_amdgcn_fence(__ATOMIC_RELEASE, "agent");
            asm volatile("s_waitcnt vmcnt(0)" ::: "memory");
            const unsigned og = xb_add(&bar[XB_TOP], 1u);
            const unsigned tg = og / nx;
            if (og + 1u == (tg + 1u) * nx) xb_add(&bar[XB_TOPGEN], 1u);
            else XB_SPIN(xb_ld(&bar[XB_TOPGEN]) == tg, bar);
            __builtin_amdgcn_fence(__ATOMIC_ACQUIRE, "agent");
            xb_add(&bar[XB_XGEN(b.x)], 1u);
            asm volatile("s_waitcnt vmcnt(0)" ::: "memory");
        } else {
            XB_SPIN(xb_ld(&bar[XB_XGEN(b.x)]) == gen, bar);
            __builtin_amdgcn_fence(__ATOMIC_ACQUIRE, "agent");
            asm volatile("s_waitcnt vmcnt(0)" ::: "memory");
        }
    }
    __syncthreads();
}

__global__ void __launch_bounds__(512, 2) yoco_fwd(Args a) {
    extern __shared__ __attribute__((aligned(16))) unsigned char lds_raw[];
    LAS unsigned char* lds = (LAS unsigned char*)lds_raw;
    cg::grid_group grid = cg::this_grid();
    unsigned char* ws = a.ws;
    const int lo = a.ph_lo, hi = a.ph_hi;
    volatile LAS unsigned* xst = (volatile LAS unsigned*)(lds + XB_ST_OFF);
    if (threadIdx.x < 4) xst[threadIdx.x] = 0u;
    __syncthreads();
    const XcdBarrier xb = xcd_barrier_post((unsigned*)(ws + WS_BAR), xst);
#define IN(k) (lo <= (k) && (k) < hi)
#define SEAM(k) do { if (IN(k) && IN((k) + 1)) xcd_barrier(xb); } while (0)
    if (a.ph_hi > 1000) grid.sync();
#define RUN(k, F) do { if (IN(k)) { if constexpr ((PROBE_MASK >> (k)) & 1) F<true>(a, lds); F<false>(a, lds); } } while (0)
    if (IN(0)) { if (PROBE_MASK & 1) p0_prologue(a, lds); p0_prologue(a, lds); }
    SEAM(0);
    RUN(1, ph1); SEAM(1);
    RUN(2, p2_spatial); SEAM(2);
    RUN(3, ph3); SEAM(3);
    RUN(4, ph4); SEAM(4);
    RUN(5, p5_attention); if (IN(5) && IN(7)) grid.sync();
    RUN(7, ph7); SEAM(7);
    RUN(8, p8_final);
#undef RUN
#undef IN
#undef SEAM
}

#ifndef N_LAUNCHES
#define N_LAUNCHES 1
#endif
extern "C" void kernel_launch(void* const* d_in, const int* in_sizes, int n_in, void* d_out, int out_size, void* d_ws, size_t ws_size, hipStream_t stream) {
    static int grid = 0;
    if (grid == 0) {
        if (n_in != 19 || out_size != MT * DM || ws_size < WS_END + ((size_t)64 << 20)) { fprintf(stderr, "kernel_launch: unexpected shapes (n_in %d out %d ws %zu need %zu)\n", n_in, out_size, ws_size, (size_t)WS_END); grid = -1; return; }
        int dev = 0, cus = 0, per_cu = 0;
        if (hipGetDevice(&dev) != hipSuccess || hipDeviceGetAttribute(&cus, hipDeviceAttributeMultiprocessorCount, dev) != hipSuccess) { grid = -1; return; }
        if (hipFuncSetAttribute((const void*)yoco_fwd, hipFuncAttributeMaxDynamicSharedMemorySize, LDS_BYTES) != hipSuccess) { fprintf(stderr, "kernel_launch: hipFuncSetAttribute failed\n"); grid = -1; return; }
        if (hipOccupancyMaxActiveBlocksPerMultiprocessor(&per_cu, (const void*)yoco_fwd, 512, LDS_BYTES) != hipSuccess || per_cu < 1) { fprintf(stderr, "kernel_launch: occupancy query says %d\n", per_cu); per_cu = 1; }
        (void)hipGetLastError();
        grid = cus;
    }
    if (grid < 0) return;
    Args a{};
    for (int i = 0; i < 19; ++i) a.in[i] = (const float*)d_in[i];
    a.out = (float*)d_out; a.ws = (unsigned char*)d_ws; a.rep = PROBE_MASK;
    (void)hipMemsetAsync((char*)d_ws + WS_BAR, 0, XCD_BAR_WORDS * sizeof(unsigned), stream);
#if N_LAUNCHES == 1
    a.ph_lo = 0; a.ph_hi = 9;
    void* args[] = {&a};
    hipError_t e = hipLaunchCooperativeKernel((const void*)yoco_fwd, dim3(grid), dim3(512), args, LDS_BYTES, stream);
    if (e != hipSuccess) fprintf(stderr, "cooperative launch failed: %s (grid %d)\n", hipGetErrorString(e), grid);
#else
    for (int p = 0; p < 9; ++p) { a.ph_lo = p; a.ph_hi = p + 1; hipLaunchKernelGGL(yoco_fwd, dim3(grid), dim3(512), LDS_BYTES, stream, a); }
#endif
}
```

```cpp
#include <hip/hip_runtime.h>
#include <hip/hip_cooperative_groups.h>
#include <cstdio>
#include <cstdint>
namespace cg = cooperative_groups;

#define LAS __attribute__((address_space(3)))
typedef unsigned short bf16_t;
typedef short bf16x8 __attribute__((ext_vector_type(8)));
typedef short bf16x4 __attribute__((ext_vector_type(4)));
typedef float f32x4 __attribute__((ext_vector_type(4)));
typedef float f32x16 __attribute__((ext_vector_type(16)));
typedef unsigned u32x4 __attribute__((ext_vector_type(4)));
typedef unsigned u32x2 __attribute__((ext_vector_type(2)));

constexpr int MT = 65536;
constexpr int DM = 1024;
constexpr int EW = 2048;
constexpr int SEQ = 2048;
constexpr float EPS = 1e-6f;
constexpr float LAM_INIT = 0.35550906759f;
constexpr float QSCALE = 0.08838834764831845f * 1.4426950408889634f;

constexpr size_t WS_CTL   = 0;
constexpr size_t WS_RSTD1 = 4096;
constexpr size_t WS_LNSUM = WS_RSTD1 + (size_t)MT * 4;
constexpr size_t WS_LNSQ  = WS_LNSUM + (size_t)MT * 4;
constexpr size_t WS_RSS2  = WS_LNSQ + (size_t)MT * 4;
constexpr size_t WS_RSS3  = WS_RSS2 + (size_t)MT * 4;
constexpr size_t WS_R0    = WS_RSS3 + (size_t)MT * 4;
constexpr size_t WS_WSB   = WS_R0 + 16 * 128 * 4;
constexpr size_t WS_WINT  = WS_WSB + 16 * 128 * 128 * 2;
constexpr size_t WS_WOUTT = WS_WINT + (size_t)6144 * 1024 * 2;
constexpr size_t WS_WBT   = WS_WOUTT + (size_t)1024 * 2048 * 2;
constexpr size_t WS_WOT   = WS_WBT + (size_t)8192 * 1024 * 2;
constexpr size_t WS_XB    = WS_WOT + (size_t)1024 * 2048 * 2;
constexpr size_t WS_UZ    = WS_XB + (size_t)MT * DM * 2;
constexpr size_t WS_GVT   = WS_UZ + (size_t)MT * EW * 2;
constexpr size_t WS_Q     = WS_GVT + (size_t)MT * EW * 2;
constexpr size_t WS_END   = WS_Q + (size_t)MT * EW * 2;

constexpr size_t WS_DUMMY = WS_END;
constexpr size_t DRY_MASK = ((size_t)1 << 22) - 1;
constexpr size_t WS_BAR = WS_END + ((size_t)60 << 20);
constexpr int XB_ST_OFF = 131072 + 4032;
constexpr int LDS_BYTES = 131072 + 4096;
constexpr int MISC_OFF = 131072;

__device__ __forceinline__ unsigned cvt_pk_bf16(float lo, float hi) { unsigned r; asm volatile("v_cvt_pk_bf16_f32 %0, %1, %2" : "=v"(r) : "v"(lo), "v"(hi)); return r; }
__device__ __forceinline__ float bf2f(unsigned short b) { return __uint_as_float(((unsigned)b) << 16); }
__device__ __forceinline__ float gelu_t(float x) {
    const float y = x * (1.0f + 0.044715f * x * x);
    const float e = __builtin_amdgcn_exp2f(-2.302208198f * y);
    return x * __builtin_amdgcn_rcpf(1.0f + e);
}
__device__ __forceinline__ float gelu_silu(float u, float z) {
    const float y = u * (1.0f + 0.044715f * u * u);
    const float ea = __builtin_amdgcn_exp2f(-2.302208198f * y), ez = __builtin_amdgcn_exp2f(-1.4426950408889634f * z);
    return (u * z) * __builtin_amdgcn_rcpf((1.0f + ea) * (1.0f + ez));
}
template <int CTRL> __device__ __forceinline__ float dppf(float x) { return __int_as_float(__builtin_amdgcn_update_dpp(0, __float_as_int(x), CTRL, 0xF, 0xF, true)); }
__device__ __forceinline__ float row16_sum(float x) { x += dppf<0xB1>(x); x += dppf<0x4E>(x); x += dppf<0x141>(x); x += dppf<0x140>(x); return x; }
__device__ __forceinline__ void pin(float& v) { asm volatile("" : "+v"(v)); }
__device__ __forceinline__ void pin4(f32x4& v) { asm volatile("" : "+v"(v)); }
__device__ __forceinline__ void pinu4(u32x4& v) { asm volatile("" : "+v"(v)); }
__device__ __forceinline__ float silu_f(float z) { return z * __builtin_amdgcn_rcpf(1.0f + __builtin_amdgcn_exp2f(-1.4426950408889634f * z)); }

namespace pg8 {
constexpr int BM = 256, BK = 64, HALF = 128, HTB = HALF * BK * 2, STAGE_BYTES = 8 * HTB, NXCD = 8, WGM = 8;
__host__ __device__ __forceinline__ int lds_byte(int r, int c) { const int st = (r >> 4) * 2 + (c >> 5), rr = r & 15, cc = c & 31, ob = rr * 64 + cc * 2; return st * 1024 + (ob ^ (((ob >> 9) & 1) << 5)); }
__host__ __device__ __forceinline__ void stage_rc(int b, int& R, int& C) { const int st = b / 1024, sb = b % 1024, swz = sb ^ (((sb >> 9) & 1) << 5); R = (st >> 1) * 16 + swz / 64; C = (st & 1) * 32 + (swz % 64) / 2; }
__host__ __device__ __forceinline__ int perm32(int rho) { const int n = rho >> 4, i = rho & 15; return 8 * (i >> 2) + 4 * n + (i & 3); }

struct Unit { int pm, pn; };
struct Gemm { const bf16_t* A; const bf16_t* Bt; int M, N, K; };

struct StaticOrder {
    int nM, nN, nwg, G, c;
    __device__ void init(int M, int N, int G_, int c_) { nM = M / BM; nN = N / BM; nwg = nM * nN; G = G_; c = c_; }
    __device__ bool next(int i, Unit& u) const {
        const long L = (long)i * G + c; if (L >= nwg) return false;
        int wgid = (int)L; { const int q = nwg / NXCD, r = nwg % NXCD, xcd = wgid % NXCD, off = wgid / NXCD; wgid = (xcd < r ? xcd * (q + 1) : r * (q + 1) + (xcd - r) * q) + off; }
        const int nig = WGM * nN, gid = wgid / nig, fm = gid * WGM, gsz = (nM - fm) < WGM ? (nM - fm) : WGM;
        u.pm = fm + ((wgid % nig) % gsz); u.pn = (wgid % nig) / gsz; return true;
    }
};

template <class Epi>
__device__ __forceinline__ void gemm_phase(LAS unsigned char* lds, const Gemm g, const StaticOrder& S, const Epi& E) {
    const int tid = threadIdx.x, wid = __builtin_amdgcn_readfirstlane(tid >> 6), lane = tid & 63, wr = wid >> 2, wc = wid & 3, fr = lane & 15, fq = lane >> 4;
    const int K = g.K, nt = K / BK;
    unsigned voffA[2], voffB[2];
#pragma unroll
    for (int i = 0; i < 2; ++i) { int R, C; stage_rc(tid * 16 + i * 8192, R, C); const int Rb = Epi::PERM ? ((R & ~31) + perm32(R & 31)) : R;
        voffA[i] = (unsigned)(R * K + C) * 2u; voffB[i] = (unsigned)(Rb * K + C) * 2u; }
    const size_t kstep = (size_t)(BK * 2);
    const size_t hstep = (size_t)HALF * K * 2;
    const size_t tstep = 2 * hstep;
    const unsigned ldsw = (unsigned)wid * 1024u;
    const int aoff = lds_byte(wr * 64 + fr, fq * 8), boff = lds_byte(wc * 32 + fr, fq * 8);
#define PG8_SA(b, h) (((b) * 2 + (h)) * HTB)
#define PG8_SB(b, h) ((4 + (b) * 2 + (h)) * HTB)
#define PG8_STAGE(bufoff, gbase, voff) do { _Pragma("unroll") for (int _i = 0; _i < 2; ++_i) \
        __builtin_amdgcn_global_load_lds((const unsigned*)((const char*)(gbase) + (voff)[_i]), (LAS unsigned*)(lds + (bufoff) + ldsw + _i * 8192), 16, 0, 0); } while (0)
#define PG8_LDA(dst, b, h) do { _Pragma("unroll") for (int m = 0; m < 4; ++m) _Pragma("unroll") for (int k = 0; k < 2; ++k) dst[m][k] = *(const LAS bf16x8*)(lds + PG8_SA(b, h) + aoff + m * 2048 + k * 1024); } while (0)
#define PG8_LDB(dst, b, h) do { _Pragma("unroll") for (int n = 0; n < 2; ++n) _Pragma("unroll") for (int k = 0; k < 2; ++k) dst[n][k] = *(const LAS bf16x8*)(lds + PG8_SB(b, h) + boff + n * 2048 + k * 1024); } while (0)
#define PG8_MMA(ai, bj, At, Bt) do { __builtin_amdgcn_s_setprio(1); _Pragma("unroll") for (int m = 0; m < 4; ++m) _Pragma("unroll") for (int n = 0; n < 2; ++n) _Pragma("unroll") for (int k = 0; k < 2; ++k) \
        acc[ai][bj][m][n] = Epi::SWAP ? __builtin_amdgcn_mfma_f32_16x16x32_bf16(At[m][k], Bt[n][k], acc[ai][bj][m][n], 0, 0, 0) \
                                      : __builtin_amdgcn_mfma_f32_16x16x32_bf16(Bt[n][k], At[m][k], acc[ai][bj][m][n], 0, 0, 0); __builtin_amdgcn_s_setprio(0); } while (0)
#define PG8_WAIT_V(n) asm volatile("s_waitcnt vmcnt(" #n ")" ::: "memory")
#define PG8_WAIT_L(n) asm volatile("s_waitcnt lgkmcnt(" #n ")" ::: "memory")
#define PG8_BAR __builtin_amdgcn_s_barrier()
#define PG8_SCHED __builtin_amdgcn_sched_barrier(0)
    Unit cur, nxt; int ui = 0;
    if (!S.next(0, cur)) return;
    f32x4 acc[2][2][4][2];
#pragma unroll
    for (int a = 0; a < 2; ++a)
#pragma unroll
        for (int b = 0; b < 2; ++b)
#pragma unroll
            for (int m = 0; m < 4; ++m)
#pragma unroll
                for (int n = 0; n < 2; ++n) acc[a][b][m][n] = (f32x4){0.f, 0.f, 0.f, 0.f};
    bf16x8 At[4][2], B0[2][2], B1[2][2];
    const char* cA = (const char*)g.A + (size_t)cur.pm * tstep; const char* cB = (const char*)g.Bt + (size_t)cur.pn * tstep;
    PG8_STAGE(PG8_SB(0, 0), cB, voffB); PG8_STAGE(PG8_SB(0, 1), cB + hstep, voffB); PG8_STAGE(PG8_SA(0, 0), cA, voffA); PG8_STAGE(PG8_SA(0, 1), cA + hstep, voffA);
    if (wr == 1) PG8_BAR;
    PG8_WAIT_V(2); PG8_BAR;
    PG8_STAGE(PG8_SB(1, 0), cB + kstep, voffB); PG8_STAGE(PG8_SA(1, 0), cA + kstep, voffA); PG8_STAGE(PG8_SB(1, 1), cB + hstep + kstep, voffB);
    PG8_WAIT_V(6); PG8_BAR;
    for (;;) {
        const bool has_next = S.next(ui + 1, nxt);
        const char* nA = has_next ? (const char*)g.A + (size_t)nxt.pm * tstep : cA; const char* nB = has_next ? (const char*)g.Bt + (size_t)nxt.pn * tstep : cB;
        for (int t = 0; t < nt; t += 2) {
            const bool last = (t == nt - 2);
            const char* a1 = cA + (size_t)(t + 1) * kstep;
            const char* a2 = last ? nA : cA + (size_t)(t + 2) * kstep; const char* b2 = last ? nB : cB + (size_t)(t + 2) * kstep;
            const char* a3 = a2 + kstep; const char* b3 = b2 + kstep;
            PG8_LDB(B0, 0, 0); PG8_LDB(B1, 0, 1); PG8_SCHED; PG8_LDA(At, 0, 0); PG8_STAGE(PG8_SA(1, 1), a1 + hstep, voffA);
            PG8_WAIT_V(8); PG8_WAIT_L(0); PG8_BAR; PG8_MMA(0, 0, At, B0); PG8_MMA(0, 1, At, B1); PG8_BAR; PG8_SCHED;
            PG8_LDA(At, 0, 1); PG8_STAGE(PG8_SB(0, 0), b2, voffB); PG8_STAGE(PG8_SB(0, 1), b2 + hstep, voffB); PG8_STAGE(PG8_SA(0, 0), a2, voffA);
            PG8_WAIT_V(8); PG8_WAIT_L(0); PG8_BAR; PG8_MMA(1, 0, At, B0); PG8_MMA(1, 1, At, B1); PG8_BAR; PG8_SCHED;
            PG8_LDB(B0, 1, 0); PG8_LDB(B1, 1, 1); PG8_SCHED; PG8_LDA(At, 1, 0); PG8_STAGE(PG8_SA(0, 1), a2 + hstep, voffA);
            PG8_WAIT_V(8); PG8_WAIT_L(0); PG8_BAR; PG8_MMA(0, 0, At, B0); PG8_MMA(0, 1, At, B1); PG8_BAR; PG8_SCHED;
            PG8_LDA(At, 1, 1); PG8_STAGE(PG8_SB(1, 0), b3, voffB); PG8_STAGE(PG8_SB(1, 1), b3 + hstep, voffB); PG8_STAGE(PG8_SA(1, 0), a3, voffA);
            PG8_WAIT_V(8); PG8_WAIT_L(0); PG8_BAR; PG8_MMA(1, 0, At, B0); PG8_MMA(1, 1, At, B1); PG8_BAR; PG8_SCHED;
        }
        if (wr == 0) PG8_BAR;
        E(acc, cur, wr, wc, fr, fq);
        if (!has_next) break;
#pragma unroll
        for (int a = 0; a < 2; ++a)
#pragma unroll
            for (int b = 0; b < 2; ++b)
#pragma unroll
                for (int m = 0; m < 4; ++m)
#pragma unroll
                    for (int n = 0; n < 2; ++n) acc[a][b][m][n] = (f32x4){0.f, 0.f, 0.f, 0.f};
        cur = nxt; cA = nA; cB = nB; ++ui;
        if (wr == 1) PG8_BAR;
    }
    PG8_WAIT_V(0);
    PG8_BAR;
#undef PG8_SA
#undef PG8_SB
#undef PG8_STAGE
#undef PG8_LDA
#undef PG8_LDB
#undef PG8_MMA
#undef PG8_WAIT_V
#undef PG8_WAIT_L
#undef PG8_BAR
#undef PG8_SCHED
}
}
using pg8::Unit;

template <bool DRY> struct EpiUZ {
    static constexpr size_t mask = DRY ? DRY_MASK : ~(size_t)0;
    static constexpr bool PERM = true, SWAP = false;
    bf16_t* UZ; const float* rstd;
    __device__ __forceinline__ void operator()(f32x4 (&acc)[2][2][4][2], const Unit& u, int wr, int wc, int fr, int fq) const {
        const int row0 = u.pm * 256 + wr * 64 + fr, col0 = u.pn * 128 + wc * 32 + 8 * fq;
        float rsv[8];
#pragma unroll
        for (int i = 0; i < 8; ++i) rsv[i] = rstd[row0 + (i >> 2) * 128 + (i & 3) * 16];
#pragma unroll
        for (int i = 0; i < 8; ++i) pin(rsv[i]);
#pragma unroll
        for (int ai = 0; ai < 2; ++ai)
#pragma unroll
            for (int m = 0; m < 4; ++m) {
                const int row = row0 + ai * 128 + m * 16; const float rs = rsv[ai * 4 + m];
                unsigned o[4];
#pragma unroll
                for (int n = 0; n < 2; ++n) {
                    const f32x4 uu = acc[ai][0][m][n] * rs, zz = acc[ai][1][m][n] * rs;
                    const float y0 = gelu_silu(uu[0], zz[0]), y1 = gelu_silu(uu[1], zz[1]), y2 = gelu_silu(uu[2], zz[2]), y3 = gelu_silu(uu[3], zz[3]);
                    o[2 * n] = cvt_pk_bf16(y0, y1); o[2 * n + 1] = cvt_pk_bf16(y2, y3);
                }
                *(u32x4*)(UZ + (((size_t)row * EW + col0) & mask)) = (u32x4){o[0], o[1], o[2], o[3]};
            }
    }
};
template <bool DRY> struct EpiGV {
    static constexpr size_t mask = DRY ? DRY_MASK : ~(size_t)0;
    static constexpr bool PERM = false, SWAP = true;
    bf16_t* GVT; const float* rstd; float* lnsum; float* lnsq;
    __device__ __forceinline__ void operator()(f32x4 (&acc)[2][2][4][2], const Unit& u, int wr, int wc, int fr, int fq) const {
        const int ch0 = u.pn * 256 + wc * 32 + fr;
        f32x4 rsv[8];
#pragma unroll
        for (int i = 0; i < 8; ++i) rsv[i] = *(const f32x4*)(rstd + u.pm * 256 + (i >> 2) * 128 + wr * 64 + (i & 3) * 16 + 4 * fq);
#pragma unroll
        for (int i = 0; i < 8; ++i) pin4(rsv[i]);
#pragma unroll
        for (int ai = 0; ai < 2; ++ai)
#pragma unroll
            for (int m = 0; m < 4; ++m) {
                const int t0 = wr * 64 + m * 16 + 4 * fq, tok = u.pm * 256 + ai * 128 + t0, cidx = u.pm * 2 + ai;
                const f32x4 rs = rsv[ai * 4 + m];
                f32x4 s1 = {0.f, 0.f, 0.f, 0.f}, s2 = {0.f, 0.f, 0.f, 0.f};
#pragma unroll
                for (int bj = 0; bj < 2; ++bj)
#pragma unroll
                    for (int n = 0; n < 2; ++n) {
                        const f32x4 v = acc[ai][bj][m][n] * rs;
                        f32x4 gq; gq[0] = gelu_t(v[0]); gq[1] = gelu_t(v[1]); gq[2] = gelu_t(v[2]); gq[3] = gelu_t(v[3]);
                        const unsigned p0 = cvt_pk_bf16(gq[0], gq[1]), p1 = cvt_pk_bf16(gq[2], gq[3]);
                        f32x4 gr; gr[0] = __uint_as_float(p0 << 16); gr[1] = __uint_as_float(p0 & 0xffff0000u); gr[2] = __uint_as_float(p1 << 16); gr[3] = __uint_as_float(p1 & 0xffff0000u);
                        s1 += gr; s2 += gr * gr;
                        const int ch = ch0 + bj * 128 + n * 16;
                        *(u32x2*)(GVT + ((((size_t)cidx * EW + ch) * 128 + t0) & mask)) = (u32x2){p0, p1};
                    }
                float val = 0.f;
#pragma unroll
                for (int j = 0; j < 4; ++j) {
                    const float a = row16_sum(s1[j]), b = row16_sum(s2[j]);
                    val = (fr == 2 * j) ? a : val; val = (fr == 2 * j + 1) ? b : val;
                }
                if (fr < 8) atomicAdd(lnsum + (size_t)(fr & 1) * MT + ((size_t)(tok + (fr >> 1)) & mask), val);
            }
    }
};
template <bool DRY> struct EpiH1 {
    static constexpr size_t mask = DRY ? DRY_MASK : ~(size_t)0;
    static constexpr bool PERM = true, SWAP = false;
    const float* x; float* out; bf16_t* HB; float* rss;
    __device__ __forceinline__ void operator()(f32x4 (&acc)[2][2][4][2], const Unit& u, int wr, int wc, int fr, int fq) const {
        const int row0 = u.pm * 256 + wr * 64 + fr, col0 = u.pn * 256 + wc * 32 + 8 * fq;
#pragma unroll
        for (int ai = 0; ai < 2; ++ai)
#pragma unroll
            for (int m = 0; m < 4; ++m)
#pragma unroll
                for (int bj = 0; bj < 2; ++bj) {
                    const size_t off = (size_t)(row0 + ai * 128 + m * 16) * DM + col0 + bj * 128;
                    acc[ai][bj][m][0] += *(const f32x4*)(x + off); acc[ai][bj][m][1] += *(const f32x4*)(x + off + 4);
                }
#pragma unroll
        for (int ai = 0; ai < 2; ++ai)
#pragma unroll
            for (int bj = 0; bj < 2; ++bj)
#pragma unroll
                for (int m = 0; m < 4; ++m) { pin4(acc[ai][bj][m][0]); pin4(acc[ai][bj][m][1]); }
#pragma unroll
        for (int ai = 0; ai < 2; ++ai)
#pragma unroll
            for (int m = 0; m < 4; ++m) {
                const int row = row0 + ai * 128 + m * 16; float ss = 0.f;
#pragma unroll
                for (int bj = 0; bj < 2; ++bj) {
                    const size_t off = (size_t)row * DM + col0 + bj * 128;
                    const f32x4 h0 = acc[ai][bj][m][0], h1 = acc[ai][bj][m][1];
                    *(u32x4*)(HB + (off & mask)) = (u32x4){cvt_pk_bf16(h0[0], h0[1]), cvt_pk_bf16(h0[2], h0[3]), cvt_pk_bf16(h1[0], h1[1]), cvt_pk_bf16(h1[2], h1[3])};
                    ss += h0[0] * h0[0] + h0[1] * h0[1] + h0[2] * h0[2] + h0[3] * h0[3] + h1[0] * h1[0] + h1[1] * h1[1] + h1[2] * h1[2] + h1[3] * h1[3];
                }
                ss += __shfl_xor(ss, 16); ss += __shfl_xor(ss, 32);
                if (fq == 0) atomicAdd(rss + ((size_t)row & mask), ss);
            }
    }
};
#ifndef PROBE_NOEPI
#define PROBE_NOEPI 0
#endif
__device__ __forceinline__ float acc_sum(const f32x4 (&acc)[2][2][4][2]) { float t = 0.f;
#pragma unroll
    for (int a = 0; a < 2; ++a)
#pragma unroll
        for (int b = 0; b < 2; ++b)
#pragma unroll
            for (int m = 0; m < 4; ++m)
#pragma unroll
                for (int n = 0; n < 2; ++n) t += acc[a][b][m][n][0] + acc[a][b][m][n][1] + acc[a][b][m][n][2] + acc[a][b][m][n][3];
    return t; }
template <bool DRY> struct EpiKQ {
    static constexpr size_t mask = DRY ? DRY_MASK : ~(size_t)0;
    static constexpr bool PERM = true, SWAP = false;
    bf16_t* KT; bf16_t* Q; bf16_t* Zb; const float* rss;
    __device__ __forceinline__ void operator()(f32x4 (&acc)[2][2][4][2], const Unit& u, int wr, int wc, int fr, int fq) const {
        if (DRY && PROBE_NOEPI) { const float t = acc_sum(acc); if (t == 1.2345e30f) KT[0] = 1; return; }
        const int row0 = u.pm * 256 + wr * 64 + fr;
        const bool isK = u.pn < 8;
        float rsv[8];
#pragma unroll
        for (int i = 0; i < 8; ++i) rsv[i] = rss[row0 + (i >> 2) * 128 + (i & 3) * 16];
#pragma unroll
        for (int i = 0; i < 8; ++i) pin(rsv[i]);
#pragma unroll
        for (int ai = 0; ai < 2; ++ai)
#pragma unroll
            for (int m = 0; m < 4; ++m) {
                const int row = row0 + ai * 128 + m * 16; const float rs = __builtin_amdgcn_rsqf(rsv[ai * 4 + m] * (1.0f / DM) + EPS);
#pragma unroll
                for (int bj = 0; bj < 2; ++bj) {
                    f32x4 v0 = acc[ai][bj][m][0] * rs, v1 = acc[ai][bj][m][1] * rs;
                    if (u.pn >= 16) {
#pragma unroll
                        for (int j = 0; j < 4; ++j) { v0[j] = silu_f(v0[j]); v1[j] = silu_f(v1[j]); }
                    }
                    const u32x4 pk = (u32x4){cvt_pk_bf16(v0[0], v0[1]), cvt_pk_bf16(v0[2], v0[3]), cvt_pk_bf16(v1[0], v1[1]), cvt_pk_bf16(v1[2], v1[3])};
                    if (u.pn >= 16) {
                        *(u32x4*)(Zb + (((size_t)row * EW + (u.pn - 16) * 256 + bj * 128 + wc * 32 + 8 * fq) & mask)) = pk;
                    } else if (isK) {
                        const int b = u.pm >> 3, kt = (u.pm & 7) * 4 + ai * 2 + wr, ks = m >> 1, r = (m & 1) * 16 + fr, c = 4 * wc + fq, bh = b * 8 + u.pn;
                        const size_t off = ((((((size_t)bh * 32 + kt) * 2 + bj) * 2 + ks) * 16 + c) * 32 + r) * 8;
                        *(u32x4*)(KT + (off & mask)) = pk;
                    } else {
                        *(u32x4*)(Q + (((size_t)row * EW + (u.pn - 8) * 256 + bj * 128 + wc * 32 + 8 * fq) & mask)) = pk;
                    }
                }
            }
    }
};
template <bool DRY> struct EpiVT {
    static constexpr size_t mask = DRY ? DRY_MASK : ~(size_t)0;
    static constexpr bool PERM = false, SWAP = true;
    bf16_t* VT; const float* rss;
    __device__ __forceinline__ void operator()(f32x4 (&acc)[2][2][4][2], const Unit& u, int wr, int wc, int fr, int fq) const {
        if (DRY && PROBE_NOEPI) { const float t = acc_sum(acc); if (t == 1.2345e30f) VT[0] = 1; return; }
        const int bh = (u.pm >> 3) * 8 + u.pn;
        f32x4 rsv[8];
#pragma unroll
        for (int i = 0; i < 8; ++i) rsv[i] = *(const f32x4*)(rss + u.pm * 256 + (i >> 2) * 128 + wr * 64 + (i & 3) * 16 + 4 * fq);
#pragma unroll
        for (int i = 0; i < 8; ++i) pin4(rsv[i]);
#pragma unroll
        for (int ai = 0; ai < 2; ++ai)
#pragma unroll
            for (int m = 0; m < 4; ++m) {
                const f32x4 q = rsv[ai * 4 + m];
                f32x4 rs; rs[0] = __builtin_amdgcn_rsqf(q[0] * (1.0f / DM) + EPS); rs[1] = __builtin_amdgcn_rsqf(q[1] * (1.0f / DM) + EPS); rs[2] = __builtin_amdgcn_rsqf(q[2] * (1.0f / DM) + EPS); rs[3] = __builtin_amdgcn_rsqf(q[3] * (1.0f / DM) + EPS);
                const int kt = (u.pm & 7) * 4 + ai * 2 + wr;
#pragma unroll
                for (int bj = 0; bj < 2; ++bj)
#pragma unroll
                    for (int n = 0; n < 2; ++n) {
                        const f32x4 v = acc[ai][bj][m][n] * rs;
                        const int et = bj * 4 + wc, r = n * 16 + fr;
                        const size_t off = ((size_t)bh * 32 + kt) * 16384 + (size_t)(((et * 4 + m) * 32 + r) * 16 + 8 * ((fq & 1) ^ ((r >> 3) & 1)) + 4 * (fq >> 1));
                        *(u32x2*)(VT + (off & mask)) = (u32x2){cvt_pk_bf16(v[0], v[1]), cvt_pk_bf16(v[2], v[3])};
                    }
            }
    }
};
template <bool DRY> struct EpiZ {
    static constexpr size_t mask = DRY ? DRY_MASK : ~(size_t)0;
    static constexpr bool PERM = true, SWAP = false;
    const bf16_t* O; bf16_t* Ost; const float* rss;
    __device__ __forceinline__ void operator()(f32x4 (&acc)[2][2][4][2], const Unit& u, int wr, int wc, int fr, int fq) const {
        const int row0 = u.pm * 256 + wr * 64 + fr, col0 = u.pn * 256 + wc * 32 + 8 * fq;
        float rsv[8]; u32x4 ovv[2][4][2];
#pragma unroll
        for (int i = 0; i < 8; ++i) rsv[i] = rss[row0 + (i >> 2) * 128 + (i & 3) * 16];
#pragma unroll
        for (int ai = 0; ai < 2; ++ai)
#pragma unroll
            for (int m = 0; m < 4; ++m)
#pragma unroll
                for (int bj = 0; bj < 2; ++bj) ovv[ai][m][bj] = *(const u32x4*)(O + (size_t)(row0 + ai * 128 + m * 16) * EW + col0 + bj * 128);
#pragma unroll
        for (int i = 0; i < 8; ++i) pin(rsv[i]);
#pragma unroll
        for (int ai = 0; ai < 2; ++ai)
#pragma unroll
            for (int m = 0; m < 4; ++m) { pinu4(ovv[ai][m][0]); pinu4(ovv[ai][m][1]); }
#pragma unroll
        for (int ai = 0; ai < 2; ++ai)
#pragma unroll
            for (int m = 0; m < 4; ++m) {
                const int row = row0 + ai * 128 + m * 16; const float rs = __builtin_amdgcn_rsqf(rsv[ai * 4 + m] * (1.0f / DM) + EPS);
#pragma unroll
                for (int bj = 0; bj < 2; ++bj) {
                    const size_t off = (size_t)row * EW + col0 + bj * 128;
                    const u32x4 ov = ovv[ai][m][bj];
                    const f32x4 z0 = acc[ai][bj][m][0] * rs, z1 = acc[ai][bj][m][1] * rs;
                    u32x4 pk;
                    pk[0] = cvt_pk_bf16(__uint_as_float(ov[0] << 16) * silu_f(z0[0]), __uint_as_float(ov[0] & 0xffff0000u) * silu_f(z0[1]));
                    pk[1] = cvt_pk_bf16(__uint_as_float(ov[1] << 16) * silu_f(z0[2]), __uint_as_float(ov[1] & 0xffff0000u) * silu_f(z0[3]));
                    pk[2] = cvt_pk_bf16(__uint_as_float(ov[2] << 16) * silu_f(z1[0]), __uint_as_float(ov[2] & 0xffff0000u) * silu_f(z1[1]));
                    pk[3] = cvt_pk_bf16(__uint_as_float(ov[3] << 16) * silu_f(z1[2]), __uint_as_float(ov[3] & 0xffff0000u) * silu_f(z1[3]));
                    *(u32x4*)(Ost + (off & mask)) = pk;
                }
            }
    }
};
template <bool DRY> struct EpiH2 {
    static constexpr size_t mask = DRY ? DRY_MASK : ~(size_t)0;
    static constexpr bool PERM = true, SWAP = false;
    const bf16_t* hb; bf16_t* h2b; float* rss;
    __device__ __forceinline__ void operator()(f32x4 (&acc)[2][2][4][2], const Unit& u, int wr, int wc, int fr, int fq) const {
        const int row0 = u.pm * 256 + wr * 64 + fr, col0 = u.pn * 256 + wc * 32 + 8 * fq;
#pragma unroll
        for (int ai = 0; ai < 2; ++ai)
#pragma unroll
            for (int m = 0; m < 4; ++m)
#pragma unroll
                for (int bj = 0; bj < 2; ++bj) {
                    const size_t off = (size_t)(row0 + ai * 128 + m * 16) * DM + col0 + bj * 128;
                    const u32x4 hv = *(const u32x4*)(hb + off);
                    acc[ai][bj][m][0] += (f32x4){__uint_as_float(hv[0] << 16), __uint_as_float(hv[0] & 0xffff0000u), __uint_as_float(hv[1] << 16), __uint_as_float(hv[1] & 0xffff0000u)};
                    acc[ai][bj][m][1] += (f32x4){__uint_as_float(hv[2] << 16), __uint_as_float(hv[2] & 0xffff0000u), __uint_as_float(hv[3] << 16), __uint_as_float(hv[3] & 0xffff0000u)};
                }
#pragma unroll
        for (int ai = 0; ai < 2; ++ai)
#pragma unroll
            for (int bj = 0; bj < 2; ++bj)
#pragma unroll
                for (int m = 0; m < 4; ++m) { pin4(acc[ai][bj][m][0]); pin4(acc[ai][bj][m][1]); }
#pragma unroll
        for (int ai = 0; ai < 2; ++ai)
#pragma unroll
            for (int m = 0; m < 4; ++m) {
                const int row = row0 + ai * 128 + m * 16; float ss = 0.f;
#pragma unroll
                for (int bj = 0; bj < 2; ++bj) {
                    const size_t off = (size_t)row * DM + col0 + bj * 128;
                    const f32x4 h0 = acc[ai][bj][m][0], h1 = acc[ai][bj][m][1];
                    const u32x4 pk = (u32x4){cvt_pk_bf16(h0[0], h0[1]), cvt_pk_bf16(h0[2], h0[3]), cvt_pk_bf16(h1[0], h1[1]), cvt_pk_bf16(h1[2], h1[3])};
                    *(u32x4*)(h2b + (off & mask)) = pk;
#pragma unroll
                    for (int j = 0; j < 4; ++j) { const float a0 = __uint_as_float(pk[j] << 16), a1 = __uint_as_float(pk[j] & 0xffff0000u); ss += a0 * a0 + a1 * a1; }
                }
                ss += __shfl_xor(ss, 16); ss += __shfl_xor(ss, 32);
                if (fq == 0) atomicAdd(rss + ((size_t)row & mask), ss);
            }
    }
};

struct Args { const float* in[19]; float* out; unsigned char* ws; int ph_lo, ph_hi, rep, pad; };

__device__ __forceinline__ float wave_sum(float v) {
#pragma unroll
    for (int o = 32; o > 0; o >>= 1) v += __shfl_xor(v, o);
    return v;
}
__device__ __forceinline__ void transpose_tile(LAS float* tile, const float* W, int ldw, int K, int src, bf16_t* Wt, int n0, int k0, const float* gain, float scale) {
    const int tid = threadIdx.x;
    { const int kk = tid >> 4, c4 = tid & 15;
#pragma unroll
      for (int hk = 0; hk < 2; ++hk) { const int k = k0 + kk + 32 * hk; const f32x4 v = *(const f32x4*)(W + (size_t)k * ldw + src + 4 * c4); const float gs = (gain ? gain[k] : 1.0f) * scale;
#pragma unroll
          for (int i = 0; i < 4; ++i) tile[(4 * c4 + i) * 65 + kk + 32 * hk] = v[i] * gs; } }
    __syncthreads();
    { const int nn = tid >> 3, k8 = tid & 7; float f[8];
#pragma unroll
      for (int i = 0; i < 8; ++i) f[i] = tile[nn * 65 + 8 * k8 + i];
      *(u32x4*)(Wt + (size_t)(n0 + nn) * K + k0 + 8 * k8) = (u32x4){cvt_pk_bf16(f[0], f[1]), cvt_pk_bf16(f[2], f[3]), cvt_pk_bf16(f[4], f[5]), cvt_pk_bf16(f[6], f[7])}; }
    __syncthreads();
}

__device__ void p0_prologue(const Args& a, LAS unsigned char* lds) {
    const int tid = threadIdx.x, lane = tid & 63, wave = tid >> 6, G = gridDim.x, bid = blockIdx.x;
    unsigned char* ws = a.ws;
    { f32x4* z = (f32x4*)(ws + WS_LNSUM); const int n4 = MT;
      for (int i = bid * 512 + tid; i < n4; i += G * 512) z[i] = (f32x4){0.f, 0.f, 0.f, 0.f}; }
    if (bid == 0 && wave == 0) {
        const float* lq1 = a.in[10]; const float* lk1 = a.in[11]; const float* lq2 = a.in[12]; const float* lk2 = a.in[13];
        float s1 = lq1[lane] * lk1[lane] + lq1[lane + 64] * lk1[lane + 64], s2 = lq2[lane] * lk2[lane] + lq2[lane + 64] * lk2[lane + 64];
        s1 = wave_sum(s1); s2 = wave_sum(s2);
        if (lane == 0) ((float*)(ws + WS_CTL))[0] = __expf(s1) - __expf(s2) + LAM_INIT;
    }
    { const float* x = a.in[0]; bf16_t* XB = (bf16_t*)(ws + WS_XB); float* rstd1 = (float*)(ws + WS_RSTD1);
      const int stride = G * 8; int row = bid * 8 + wave; f32x4 v[4], vn[4];
      if (row < MT) {
#pragma unroll
          for (int i = 0; i < 2; ++i) { v[2 * i] = *(const f32x4*)(x + (size_t)row * DM + i * 512 + lane * 8); v[2 * i + 1] = *(const f32x4*)(x + (size_t)row * DM + i * 512 + lane * 8 + 4); } }
      for (; row < MT; row += stride) {
          const int nr = row + stride;
          if (nr < MT) {
#pragma unroll
              for (int i = 0; i < 2; ++i) { vn[2 * i] = *(const f32x4*)(x + (size_t)nr * DM + i * 512 + lane * 8); vn[2 * i + 1] = *(const f32x4*)(x + (size_t)nr * DM + i * 512 + lane * 8 + 4); } }
          float ss = 0.f;
#pragma unroll
          for (int i = 0; i < 4; ++i) ss += v[i][0] * v[i][0] + v[i][1] * v[i][1] + v[i][2] * v[i][2] + v[i][3] * v[i][3];
          ss = wave_sum(ss);
#pragma unroll
          for (int i = 0; i < 2; ++i)
              *(u32x4*)(XB + (size_t)row * DM + i * 512 + lane * 8) = (u32x4){cvt_pk_bf16(v[2 * i][0], v[2 * i][1]), cvt_pk_bf16(v[2 * i][2], v[2 * i][3]), cvt_pk_bf16(v[2 * i + 1][0], v[2 * i + 1][1]), cvt_pk_bf16(v[2 * i + 1][2], v[2 * i + 1][3])};
          if (lane == 0) rstd1[row] = __builtin_amdgcn_rsqf(ss * (1.0f / DM) + EPS);
#pragma unroll
          for (int i = 0; i < 4; ++i) v[i] = vn[i];
      } }
    { const float* wsp = a.in[5]; bf16_t* WSB = (bf16_t*)(ws + WS_WSB); float* r0 = (float*)(ws + WS_R0);
      for (int row = bid * 8 + wave; row < 16 * 128; row += G * 8) {
          const int t = row & 127; float s = 0.f;
#pragma unroll
          for (int i = 0; i < 2; ++i) { const int sc = lane + 64 * i; float v = (sc <= t) ? wsp[(size_t)row * 128 + sc] : 0.f; const unsigned p = cvt_pk_bf16(v, 0.f); WSB[(size_t)row * 128 + sc] = (bf16_t)(p & 0xffffu); s += __uint_as_float(p << 16); }
          s = wave_sum(s);
          if (lane == 0) r0[row] = s;
      } }
    { LAS float* tile = (LAS float*)lds;
      for (int T = bid; T < 4608; T += G) {
          const float* W; int ldw, K, src, n0, k0; bf16_t* Wt; const float* gain = nullptr; float scale = 1.0f;
          if (T < 1536) { K = 1024; const int nt_ = T >> 4; n0 = nt_ * 64; k0 = (T & 15) * 64; W = a.in[2]; ldw = 6144; Wt = (bf16_t*)(ws + WS_WINT); gain = a.in[1];
              if (n0 < 4096) { const int j = n0 >> 8, w = n0 & 255; src = (w < 128) ? 128 * j + w : 4096 + 128 * j + (w - 128); } else src = 2048 + (n0 - 4096); }
          else if (T < 2048) { const int t2 = T - 1536; K = 2048; n0 = (t2 >> 5) * 64; k0 = (t2 & 31) * 64; W = a.in[7]; ldw = 1024; Wt = (bf16_t*)(ws + WS_WOUTT); src = n0; }
          else if (T < 4096) { const int t2 = T - 2048; K = 1024; n0 = (t2 >> 4) * 64; k0 = (t2 & 15) * 64; Wt = (bf16_t*)(ws + WS_WBT); ldw = 4096;
              if (n0 < 2048) { W = a.in[17]; src = n0; gain = a.in[16]; }
              else if (n0 < 4096) { W = a.in[9]; src = n0 - 2048; gain = a.in[8]; scale = QSCALE; }
              else if (n0 < 6144) { W = a.in[9]; src = 2048 + (n0 - 4096); gain = a.in[8]; }
              else { W = a.in[17]; src = 2048 + (n0 - 6144); gain = a.in[16]; } }
          else { const int t2 = T - 4096; K = 2048; n0 = (t2 >> 5) * 64; k0 = (t2 & 31) * 64; W = a.in[15]; ldw = 1024; Wt = (bf16_t*)(ws + WS_WOT); src = n0; }
          transpose_tile(tile, W, ldw, K, src, Wt, n0, k0, gain, scale);
      } }
}

template <bool dry> __device__ void p2_spatial(const Args& a, LAS unsigned char* lds) {
    const int tid = threadIdx.x, wid = __builtin_amdgcn_readfirstlane(tid >> 6), lane = tid & 63, wr = wid >> 2, wc = wid & 3, fr = lane & 15, fq = lane >> 4;
    unsigned char* ws = a.ws;
    const bf16_t* GVT = (const bf16_t*)(ws + WS_GVT); bf16_t* UZ = (bf16_t*)(ws + WS_UZ); const bf16_t* WSB = (const bf16_t*)(ws + WS_WSB);
    const float* lnsum = (const float*)(ws + WS_LNSUM); const float* lnsq = (const float*)(ws + WS_LNSQ); const float* r0g = (const float*)(ws + WS_R0);
    const float* lng = a.in[3]; const float* lnb = a.in[4]; const float* bsg = a.in[6];
    LAS float* smu = (LAS float*)(lds + MISC_OFF); LAS float* srs = smu + 128; LAS float* sr1 = smu + 256;
    int Rr[2], Cc[2];
#pragma unroll
    for (int i = 0; i < 2; ++i) pg8::stage_rc(tid * 16 + i * 8192, Rr[i], Cc[i]);
    const int aoff = pg8::lds_byte(wr * 64 + fr, fq * 8), boff = pg8::lds_byte(wc * 32 + fr, fq * 8);
    for (int it = blockIdx.x; it < 512 * 16; it += gridDim.x) {
        const int cidx = it >> 4, g = it & 15;
        if (tid < 128) { const int tok = cidx * 128 + tid; const float mu = lnsum[tok] * (1.0f / EW); const float var = lnsq[tok] * (1.0f / EW) - mu * mu;
            smu[tid] = mu; srs[tid] = __builtin_amdgcn_rsqf(fmaxf(var, 0.f) + EPS); sr1[tid] = 0.f; }
        const bf16_t* Bt = GVT + ((size_t)cidx * EW + g * 128) * 128;
#pragma unroll
        for (int kh = 0; kh < 2; ++kh)
#pragma unroll
            for (int i = 0; i < 2; ++i) { const int Rb = (Rr[i] & ~31) + pg8::perm32(Rr[i] & 31);
                __builtin_amdgcn_global_load_lds((const unsigned*)(Bt + (size_t)Rb * 128 + kh * 64 + Cc[i]), (LAS unsigned*)(lds + 32768 + kh * 16384 + wid * 1024 + i * 8192), 16, 0, 0); }
        __syncthreads();
        const bf16_t* Aw = WSB + (size_t)g * 16384;
#pragma unroll
        for (int kh = 0; kh < 2; ++kh)
#pragma unroll
            for (int i = 0; i < 2; ++i) {
                const int R = Rr[i], C = kh * 64 + Cc[i];
                const u32x4 wv = *(const u32x4*)(Aw + (size_t)R * 128 + C);
                float f[8]; float part = 0.f;
#pragma unroll
                for (int j = 0; j < 4; ++j) { f[2 * j] = __uint_as_float(wv[j] << 16) * srs[C + 2 * j]; f[2 * j + 1] = __uint_as_float(wv[j] & 0xffff0000u) * srs[C + 2 * j + 1]; }
                u32x4 pk;
#pragma unroll
                for (int j = 0; j < 4; ++j) { pk[j] = cvt_pk_bf16(f[2 * j], f[2 * j + 1]); part += __uint_as_float(pk[j] << 16) * smu[C + 2 * j] + __uint_as_float(pk[j] & 0xffff0000u) * smu[C + 2 * j + 1]; }
                *(LAS u32x4*)(lds + kh * 16384 + tid * 16 + i * 8192) = pk;
                atomicAdd((float*)(sr1 + R), part);
            }
        asm volatile("s_waitcnt vmcnt(0)" ::: "memory");
        __syncthreads();
        f32x4 acc[4][2];
#pragma unroll
        for (int m = 0; m < 4; ++m)
#pragma unroll
            for (int n = 0; n < 2; ++n) acc[m][n] = (f32x4){0.f, 0.f, 0.f, 0.f};
#pragma unroll
        for (int kh = 0; kh < 2; ++kh)
#pragma unroll
            for (int k = 0; k < 2; ++k) {
                bf16x8 Af[4], Bf[2];
#pragma unroll
                for (int m = 0; m < 4; ++m) Af[m] = *(const LAS bf16x8*)(lds + kh * 16384 + aoff + m * 2048 + k * 1024);
#pragma unroll
                for (int n = 0; n < 2; ++n) Bf[n] = *(const LAS bf16x8*)(lds + 32768 + kh * 16384 + boff + n * 2048 + k * 1024);
#pragma unroll
                for (int m = 0; m < 4; ++m)
#pragma unroll
                    for (int n = 0; n < 2; ++n) acc[m][n] = __builtin_amdgcn_mfma_f32_16x16x32_bf16(Bf[n], Af[m], acc[m][n], 0, 0, 0);
            }
        const int c0 = wc * 32 + 8 * fq, cg0 = g * 128 + c0;
        const f32x4 g0 = *(const f32x4*)(lng + cg0), g1 = *(const f32x4*)(lng + cg0 + 4), b0 = *(const f32x4*)(lnb + cg0), b1 = *(const f32x4*)(lnb + cg0 + 4);
        u32x4 uvv[4]; float r0v[4], bsv[4];
#pragma unroll
        for (int m = 0; m < 4; ++m) { const int t = wr * 64 + m * 16 + fr; uvv[m] = *(const u32x4*)(UZ + ((size_t)cidx * 128 + t) * EW + cg0); r0v[m] = r0g[g * 128 + t]; bsv[m] = bsg[g * 128 + t]; }
#pragma unroll
        for (int m = 0; m < 4; ++m) { pinu4(uvv[m]); pin(r0v[m]); pin(bsv[m]); }
#pragma unroll
        for (int m = 0; m < 4; ++m) {
            const int t = wr * 64 + m * 16 + fr; const float r1 = sr1[t], r0 = r0v[m], bs = bsv[m];
            bf16_t* p = UZ + ((size_t)cidx * 128 + t) * EW + cg0;
            const u32x4 uv = uvv[m];
            const f32x4 s0 = g0 * (acc[m][0] - r1) + b0 * r0 + bs, s1 = g1 * (acc[m][1] - r1) + b1 * r0 + bs;
            u32x4 pk;
            pk[0] = cvt_pk_bf16(__uint_as_float(uv[0] << 16) * s0[0], __uint_as_float(uv[0] & 0xffff0000u) * s0[1]);
            pk[1] = cvt_pk_bf16(__uint_as_float(uv[1] << 16) * s0[2], __uint_as_float(uv[1] & 0xffff0000u) * s0[3]);
            pk[2] = cvt_pk_bf16(__uint_as_float(uv[2] << 16) * s1[0], __uint_as_float(uv[2] & 0xffff0000u) * s1[1]);
            pk[3] = cvt_pk_bf16(__uint_as_float(uv[3] << 16) * s1[2], __uint_as_float(uv[3] & 0xffff0000u) * s1[3]);
            *(u32x4*)(dry ? (bf16_t*)(ws + WS_DUMMY) + (((size_t)t * EW + cg0) & DRY_MASK) : p) = pk;
        }
        __syncthreads();
    }
}

__device__ __forceinline__ float max3f(float a, float b, float c) { float r; asm("v_max3_f32 %0, %1, %2, %3" : "=v"(r) : "v"(a), "v"(b), "v"(c)); return r; }
__device__ __forceinline__ float xhalf_max(float v) {
    const unsigned u = __float_as_uint(v);
    const auto sw = __builtin_amdgcn_permlane32_swap(u, u, false, false);
    const float a_ = __uint_as_float(sw[0]), b_ = __uint_as_float(sw[1]); return max3f(a_, b_, b_);
}
#ifndef PROBE_NOCOMP
#define PROBE_NOCOMP 0
#endif
#define DS_RD(dst, addr, off) asm volatile("ds_read_b128 %0, %1 offset:%2" : "=v"(dst) : "v"(addr), "n"(off))
#define LGKM(N, dst) do { asm volatile("s_waitcnt lgkmcnt(%0)" :: "n"(N) : "memory"); __builtin_amdgcn_sched_barrier(0); } while (0)
template <bool dry> __device__ void p5_attention(const Args& a, LAS unsigned char* lds) {
    const unsigned ldsb = (unsigned)(uintptr_t)lds;
    const int tid = threadIdx.x, w = __builtin_amdgcn_readfirstlane(tid >> 6), lane = tid & 63, rg = w & 3, n = w >> 2, r = lane & 31, hh = lane >> 5;
    unsigned char* ws = a.ws;
    const bf16_t* KT = (const bf16_t*)(ws + WS_UZ); const bf16_t* VT = (const bf16_t*)(ws + WS_GVT); bf16_t* QO = (bf16_t*)(ws + WS_Q);
    const float* subg = a.in[14];
    const float lam = ((const float*)(ws + WS_CTL))[0];
    const int G = gridDim.x, v0 = (G == 256) ? ((blockIdx.x & 7) * 32 + (blockIdx.x >> 3)) : blockIdx.x;
    const unsigned dmao = (unsigned)tid * 16u;
    LAS float* sg = (LAS float*)(lds + MISC_OFF);
    if (tid < 256) sg[tid] = subg[tid] * (1.0f - LAM_INIT);
    __syncthreads();
    const int koff = (((n * 2) * 16 + hh) * 32 + r) * 16;
    const int voff = 32768 + r * 32 + 16 * (hh ^ ((r >> 3) & 1));
    for (int p = v0; p < 2048; p += G) {
        const int bh = p >> 3, jj = p & 7, b = bh >> 3, h = bh & 7;
        for (int pass = 0; pass < 2; ++pass) {
            const int qb = pass == 0 ? 15 - jj : jj;
            bf16x8 Qf[8];
            { const int tok = b * SEQ + qb * 128 + rg * 32 + r;
              const bf16_t* qp = QO + (size_t)tok * EW + h * 256;
#pragma unroll
              for (int s = 0; s < 8; ++s) Qf[s] = *(const bf16x8*)(qp + n * 128 + 16 * s + 8 * hh); }
            f32x16 O[8];
#pragma unroll
            for (int e = 0; e < 8; ++e)
#pragma unroll
                for (int i = 0; i < 16; ++i) O[e][i] = 0.f;
            float m_run = -INFINITY, l_run = 0.f;
            const int nkt = 2 * qb + 2;
            const bf16_t* kbase = KT + (size_t)bh * 32 * 16384; const bf16_t* vbase = VT + (size_t)bh * 32 * 16384;
            unsigned dof0 = dmao; asm volatile("" : "+v"(dof0));
#pragma unroll
            for (int i = 0; i < 4; ++i) {
                __builtin_amdgcn_global_load_lds((const unsigned*)((const char*)kbase + i * 8192 + dof0), (LAS unsigned*)(lds + i * 8192 + w * 1024), 16, 0, 0);
                __builtin_amdgcn_global_load_lds((const unsigned*)((const char*)vbase + i * 8192 + dof0), (LAS unsigned*)(lds + 32768 + i * 8192 + w * 1024), 16, 0, 0);
            }
            asm volatile("s_waitcnt vmcnt(0)" ::: "memory");
            __builtin_amdgcn_s_barrier();
            const int q_lo = qb * 128 + rg * 32;
            for (int kt = 0; kt < nkt; ++kt) {
                const int bufo = (kt & 1) * 65536;
                const bool pf = (kt + 1 < nkt);
                const char* kg = (const char*)(kbase + (size_t)(kt + 1) * 16384); const char* vg = (const char*)(vbase + (size_t)(kt + 1) * 16384); const int nb = 65536 - bufo;
                unsigned dof = dmao; asm volatile("" : "+v"(dof));
#define DMA_X(i) do { if (pf) { if ((i) < 4) __builtin_amdgcn_global_load_lds((const unsigned*)(kg + (i) * 8192 + dof), (LAS unsigned*)(lds + nb + (i) * 8192 + w * 1024), 16, 0, 0); \
                    else if ((i) < 8) __builtin_amdgcn_global_load_lds((const unsigned*)(vg + ((i) - 4) * 8192 + dof), (LAS unsigned*)(lds + nb + 32768 + ((i) - 4) * 8192 + w * 1024), 16, 0, 0); } } while (0)
                const int key0 = kt * 64;
                const bool act0 = key0 <= q_lo + 31;
                if (act0 && !(dry && PROBE_NOCOMP)) {
                    const unsigned kb = ldsb + bufo + koff, vb = ldsb + bufo + voff;
                    u32x4 f0, f1, f2, f3, f4;
                    f32x16 S0, S1;
#pragma unroll
                    for (int i = 0; i < 16; ++i) { S0[i] = 0.f; S1[i] = 0.f; }
#define K_LOAD(F, KS, SI) DS_RD(F, kb, (KS) * 8192 + (SI) * 1024)
#define K_STEP(SV, F, SI, WN) LGKM(WN, F); SV = __builtin_amdgcn_mfma_f32_32x32x16_bf16(__builtin_bit_cast(bf16x8, F), Qf[SI], SV, 0, 0, 0); __builtin_amdgcn_sched_barrier(0)
#define V_LOAD(F, KS, E, S2) DS_RD(F, vb, (KS) * 2048 + (E) * 4096 + (S2) * 1024)
#define V_STEP(PF, F, E, S2, WN, X) LGKM(WN, F); O[E] = __builtin_amdgcn_mfma_f32_32x32x16_bf16(__builtin_bit_cast(bf16x8, F), PF[S2], O[E], 0, 0, 0); X; __builtin_amdgcn_sched_barrier(0)
#define QK_SUB(SV, KS) K_LOAD(f0, KS, 0); \
                    K_LOAD(f1, KS, 1); \
                    K_LOAD(f2, KS, 2); \
                    K_LOAD(f3, KS, 3); \
                    K_LOAD(f4, KS, 4); \
                    K_STEP(SV, f0, 0, 4); K_LOAD(f0, KS, 5); \
                    K_STEP(SV, f1, 1, 4); K_LOAD(f1, KS, 6); \
                    K_STEP(SV, f2, 2, 4); K_LOAD(f2, KS, 7); \
                    K_STEP(SV, f3, 3, 4); \
                    K_STEP(SV, f4, 4, 3); \
                    K_STEP(SV, f0, 5, 2); \
                    K_STEP(SV, f1, 6, 1); \
                    K_STEP(SV, f2, 7, 0)
#define PV_HEAD(KS) V_LOAD(f0, KS, 0, 0); V_LOAD(f1, KS, 1, 0); V_LOAD(f2, KS, 2, 0); V_LOAD(f3, KS, 3, 0); V_LOAD(f4, KS, 4, 0)
#define PV_BODY(PF, KS, X) \
                    V_STEP(PF, f0, 0, 0, 4, X(0)); V_LOAD(f0, KS, 5, 0); \
                    V_STEP(PF, f1, 1, 0, 4, X(1)); V_LOAD(f1, KS, 6, 0); \
                    V_STEP(PF, f2, 2, 0, 4, X(2)); V_LOAD(f2, KS, 7, 0); \
                    V_STEP(PF, f3, 3, 0, 4, X(3)); V_LOAD(f3, KS, 0, 1); \
                    V_STEP(PF, f4, 4, 0, 4, X(4)); V_LOAD(f4, KS, 1, 1); \
                    V_STEP(PF, f0, 5, 0, 4, X(5)); V_LOAD(f0, KS, 2, 1); \
                    V_STEP(PF, f1, 6, 0, 4, X(6)); V_LOAD(f1, KS, 3, 1); \
                    V_STEP(PF, f2, 7, 0, 4, X(7)); V_LOAD(f2, KS, 4, 1); \
                    V_STEP(PF, f3, 0, 1, 4, X(8)); V_LOAD(f3, KS, 5, 1); \
                    V_STEP(PF, f4, 1, 1, 4, X(9)); V_LOAD(f4, KS, 6, 1); \
                    V_STEP(PF, f0, 2, 1, 4, X(10)); V_LOAD(f0, KS, 7, 1); \
                    V_STEP(PF, f1, 3, 1, 4, X(11)); \
                    V_STEP(PF, f2, 4, 1, 3, X(12)); \
                    V_STEP(PF, f3, 5, 1, 2, X(13)); \
                    V_STEP(PF, f4, 6, 1, 1, X(14)); \
                    V_STEP(PF, f0, 7, 1, 0, X(15))
#define NOP_X(i) (void)0
#define EXP_X(i) S1[i] = __builtin_amdgcn_exp2f(S1[i] - m1); DMA_X(i)
#define ROWMAX(SV, MT) { const float t0 = max3f(SV[0], SV[1], SV[2]), t1 = max3f(SV[3], SV[4], SV[5]), t2 = max3f(SV[6], SV[7], SV[8]), t3 = max3f(SV[9], SV[10], SV[11]), t4 = max3f(SV[12], SV[13], SV[14]); \
                    MT = xhalf_max(max3f(max3f(t0, t1, t2), max3f(t3, t4, SV[15]), SV[15])); }
#define PACKP(PF, SV) { _Pragma("unroll") for (int s_ = 0; s_ < 2; ++s_) { const int o8 = s_ * 8; \
                    const u32x4 pk_ = (u32x4){cvt_pk_bf16(SV[o8 + 0], SV[o8 + 1]), cvt_pk_bf16(SV[o8 + 2], SV[o8 + 3]), cvt_pk_bf16(SV[o8 + 4], SV[o8 + 5]), cvt_pk_bf16(SV[o8 + 6], SV[o8 + 7])}; PF[s_] = __builtin_bit_cast(bf16x8, pk_); } }
                    __builtin_amdgcn_s_setprio(1);
                    QK_SUB(S0, 0);
                    QK_SUB(S1, 1);
                    __builtin_amdgcn_s_setprio(0);
                    const int qa = q_lo + r;
                    if (key0 + 31 > q_lo) {
#pragma unroll
                        for (int i = 0; i < 16; ++i) { const int ka = key0 + (i & 3) + 8 * (i >> 2) + 4 * hh; if (ka > qa) S0[i] = -INFINITY; }
                    }
                    float mt0; ROWMAX(S0, mt0);
                    const float m0 = (mt0 > m_run + 8.0f) ? mt0 : m_run;
                    if (__any(m0 != m_run)) {
                        const float alpha = __builtin_amdgcn_exp2f(m_run - m0);
                        l_run *= alpha;
#pragma unroll
                        for (int e = 0; e < 8; ++e)
#pragma unroll
                            for (int i = 0; i < 16; ++i) O[e][i] *= alpha;
                    }
                    m_run = m0;
                    PV_HEAD(0);
                    float ls = 0.f;
                    bf16x8 P0[2];
#pragma unroll
                    for (int h8 = 0; h8 < 2; ++h8) {
                        float pe[8];
#pragma unroll
                        for (int i = 0; i < 8; ++i) { pe[i] = __builtin_amdgcn_exp2f(S0[8 * h8 + i] - m0); ls += pe[i]; }
                        const u32x4 pk_ = (u32x4){cvt_pk_bf16(pe[0], pe[1]), cvt_pk_bf16(pe[2], pe[3]), cvt_pk_bf16(pe[4], pe[5]), cvt_pk_bf16(pe[6], pe[7])};
                        P0[h8] = __builtin_bit_cast(bf16x8, pk_);
                        __builtin_amdgcn_sched_barrier(0);
                    }
                    l_run += ls;
                    __builtin_amdgcn_sched_barrier(0);
                    {
                        if (key0 + 63 > q_lo) {
#pragma unroll
                            for (int i = 0; i < 16; ++i) { const int ka = key0 + 32 + (i & 3) + 8 * (i >> 2) + 4 * hh; if (ka > qa) S1[i] = -INFINITY; }
                        }
                        float mt1; ROWMAX(S1, mt1);
                        const float m1 = (mt1 > m0 + 8.0f) ? mt1 : m0;
                        __builtin_amdgcn_sched_barrier(0);
                        __builtin_amdgcn_s_setprio(1);
                        PV_BODY(P0, 0, EXP_X);
                        __builtin_amdgcn_s_setprio(0);
                        if (__any(m1 != m0)) {
                            const float alpha = __builtin_amdgcn_exp2f(m0 - m1);
                            l_run *= alpha;
#pragma unroll
                            for (int e = 0; e < 8; ++e)
#pragma unroll
                                for (int i = 0; i < 16; ++i) O[e][i] *= alpha;
                        }
                        m_run = m1;
                        PV_HEAD(1);
                        float ls1 = 0.f;
#pragma unroll
                        for (int i = 0; i < 16; ++i) ls1 += S1[i];
                        l_run += ls1;
                        bf16x8 P1[2];
                        PACKP(P1, S1);
                        __builtin_amdgcn_sched_barrier(0);
                        __builtin_amdgcn_s_setprio(1);
                        PV_BODY(P1, 1, NOP_X);
                        __builtin_amdgcn_s_setprio(0);
                    }
#undef K_LOAD
#undef K_STEP
#undef V_LOAD
#undef V_STEP
#undef QK_SUB
#undef PV_HEAD
#undef PV_BODY
#undef NOP_X
#undef EXP_X
#undef DMA_X
#undef ROWMAX
#undef PACKP
                }
                asm volatile("s_waitcnt vmcnt(0)" ::: "memory");
                __builtin_amdgcn_s_barrier();
            }
            const float l_tot = l_run + __shfl_xor(l_run, 32);
            if (n == 1) {
                const float sc = lam / l_tot;
#pragma unroll
                for (int e = 0; e < 8; ++e)
#pragma unroll
                    for (int g4 = 0; g4 < 4; ++g4)
                        *(LAS f32x4*)(lds + ((rg * 32 + e * 4 + g4) * 64 + lane) * 16) = (f32x4){O[e][4 * g4] * sc, O[e][4 * g4 + 1] * sc, O[e][4 * g4 + 2] * sc, O[e][4 * g4 + 3] * sc};
            }
            __syncthreads();
            if (n == 0) {
                const int lane2 = __builtin_amdgcn_mbcnt_hi(~0u, __builtin_amdgcn_mbcnt_lo(~0u, 0u)), r2 = lane2 & 31, hh2 = lane2 >> 5;
                const int tok2 = b * SEQ + qb * 128 + rg * 32 + r2;
                const float inv = 1.0f / l_tot; float ss = 0.f;
#pragma unroll
                for (int e = 0; e < 8; ++e)
#pragma unroll
                    for (int g4 = 0; g4 < 4; ++g4) {
                        const f32x4 x2 = *(const LAS f32x4*)(lds + ((rg * 32 + e * 4 + g4) * 64 + lane2) * 16);
#pragma unroll
                        for (int j = 0; j < 4; ++j) { const float o = O[e][4 * g4 + j] * inv - x2[j]; O[e][4 * g4 + j] = o; ss += o * o; }
                    }
                ss += __shfl_xor(ss, 32);
                const float rs = __builtin_amdgcn_rsqf(ss * (1.0f / 256.0f) + EPS);
                bf16_t* qst = QO + (size_t)tok2 * EW + h * 256;
                const bf16_t* zp = (const bf16_t*)a.out + (size_t)tok2 * EW + h * 256;
                u32x2 zv[8][4];
#pragma unroll
                for (int e = 0; e < 8; ++e)
#pragma unroll
                    for (int g4 = 0; g4 < 4; ++g4) zv[e][g4] = *(const u32x2*)(zp + 32 * e + 8 * g4 + 4 * hh2);
#pragma unroll
                for (int e = 0; e < 8; ++e)
#pragma unroll
                    for (int g4 = 0; g4 < 4; ++g4) asm volatile("" : "+v"(zv[e][g4]));
                if (!dry || rs == 1.2345e30f)
#pragma unroll
                for (int e = 0; e < 8; ++e)
#pragma unroll
                    for (int g4 = 0; g4 < 4; ++g4) {
                        const int e0 = 32 * e + 8 * g4 + 4 * hh2;
                        const f32x4 gn = *(const LAS f32x4*)(sg + e0);
                        const u32x2 zz = zv[e][g4];
                        *(u32x2*)(qst + e0) = (u32x2){cvt_pk_bf16(O[e][4 * g4] * rs * gn[0] * __uint_as_float(zz[0] << 16), O[e][4 * g4 + 1] * rs * gn[1] * __uint_as_float(zz[0] & 0xffff0000u)),
                                                      cvt_pk_bf16(O[e][4 * g4 + 2] * rs * gn[2] * __uint_as_float(zz[1] << 16), O[e][4 * g4 + 3] * rs * gn[3] * __uint_as_float(zz[1] & 0xffff0000u))};
                    }
            }
            __syncthreads();
        }
    }
}

template <bool dry> __device__ void p8_final(const Args& a, LAS unsigned char*) {
    const int tid = threadIdx.x, lane = tid & 63, wave = tid >> 6;
    const float* rss3 = (const float*)(a.ws + WS_RSS3); const float* fg = a.in[18]; float* out = a.out; const bf16_t* h2b = (const bf16_t*)(a.ws + WS_UZ);
    f32x4 gq[4];
#pragma unroll
    for (int i = 0; i < 4; ++i) gq[i] = *(const f32x4*)(fg + i * 256 + lane * 4);
    const int stride = gridDim.x * 8; int row = blockIdx.x * 8 + wave;
    u32x2 v[4], vn[4]; float q = 0.f, qn = 0.f;
    if (row < MT) { q = rss3[row];
#pragma unroll
        for (int i = 0; i < 4; ++i) v[i] = *(const u32x2*)(h2b + (size_t)row * DM + i * 256 + lane * 4); }
    for (; row < MT; row += stride) {
        const int nr = row + stride;
        if (nr < MT) { qn = rss3[nr];
#pragma unroll
            for (int i = 0; i < 4; ++i) vn[i] = *(const u32x2*)(h2b + (size_t)nr * DM + i * 256 + lane * 4); }
        const float rs = __builtin_amdgcn_rsqf(q * (1.0f / DM) + EPS);
        float* p = dry ? (float*)(a.ws + WS_DUMMY) + (((size_t)row * DM) & DRY_MASK) : out + (size_t)row * DM;
#pragma unroll
        for (int i = 0; i < 4; ++i) {
            const f32x4 h = (f32x4){__uint_as_float(v[i][0] << 16), __uint_as_float(v[i][0] & 0xffff0000u), __uint_as_float(v[i][1] << 16), __uint_as_float(v[i][1] & 0xffff0000u)};
            *(f32x4*)(p + i * 256 + lane * 4) = h * rs * gq[i];
        }
        q = qn;
#pragma unroll
        for (int i = 0; i < 4; ++i) v[i] = vn[i];
    }
}

#ifndef PROBE_MASK
#define PROBE_MASK 0
#endif
template <bool DRY> __device__ __forceinline__ void ph1(const Args& a, LAS unsigned char* lds) {
    unsigned char* ws = a.ws; unsigned char* dmy = ws + WS_DUMMY; const int G = gridDim.x, bid = blockIdx.x;
    { pg8::Gemm g{(const bf16_t*)(ws + WS_XB), (const bf16_t*)(ws + WS_WINT), MT, 4096, DM}; pg8::StaticOrder S; S.init(MT, 4096, G, bid);
      EpiUZ<DRY> E{DRY ? (bf16_t*)dmy : (bf16_t*)(ws + WS_UZ), (const float*)(ws + WS_RSTD1)}; pg8::gemm_phase<EpiUZ<DRY>>(lds, g, S, E); }
    { pg8::Gemm g{(const bf16_t*)(ws + WS_XB), (const bf16_t*)(ws + WS_WINT) + (size_t)4096 * DM, MT, 2048, DM}; pg8::StaticOrder S; S.init(MT, 2048, G, bid);
      EpiGV<DRY> E{DRY ? (bf16_t*)dmy : (bf16_t*)(ws + WS_GVT), (const float*)(ws + WS_RSTD1), DRY ? (float*)dmy + (1 << 23) : (float*)(ws + WS_LNSUM), DRY ? (float*)dmy + (1 << 23) : (float*)(ws + WS_LNSQ)}; pg8::gemm_phase<EpiGV<DRY>>(lds, g, S, E); }
}
template <bool DRY> __device__ __forceinline__ void ph3(const Args& a, LAS unsigned char* lds) {
    unsigned char* ws = a.ws; unsigned char* dmy = ws + WS_DUMMY; const int G = gridDim.x, bid = blockIdx.x;
    pg8::Gemm g{(const bf16_t*)(ws + WS_UZ), (const bf16_t*)(ws + WS_WOUTT), MT, DM, EW}; pg8::StaticOrder S; S.init(MT, DM, G, bid);
    EpiH1<DRY> E{a.in[0], DRY ? (float*)dmy : a.out, DRY ? (bf16_t*)dmy : (bf16_t*)(ws + WS_XB), DRY ? (float*)dmy + (1 << 23) : (float*)(ws + WS_RSS2)}; pg8::gemm_phase<EpiH1<DRY>>(lds, g, S, E);
}
template <bool DRY> __device__ __forceinline__ void ph4(const Args& a, LAS unsigned char* lds) {
    unsigned char* ws = a.ws; unsigned char* dmy = ws + WS_DUMMY; const int G = gridDim.x, bid = blockIdx.x;
    { pg8::Gemm g{(const bf16_t*)(ws + WS_XB), (const bf16_t*)(ws + WS_WBT), MT, 6144, DM}; pg8::StaticOrder S; S.init(MT, 6144, G, bid);
      EpiKQ<DRY> E{DRY ? (bf16_t*)dmy : (bf16_t*)(ws + WS_UZ), DRY ? (bf16_t*)dmy : (bf16_t*)(ws + WS_Q), DRY ? (bf16_t*)dmy : (bf16_t*)a.out, (const float*)(ws + WS_RSS2)}; pg8::gemm_phase<EpiKQ<DRY>>(lds, g, S, E); }
    { pg8::Gemm g{(const bf16_t*)(ws + WS_XB), (const bf16_t*)(ws + WS_WBT) + (size_t)6144 * DM, MT, 2048, DM}; pg8::StaticOrder S; S.init(MT, 2048, G, bid);
      EpiVT<DRY> E{DRY ? (bf16_t*)dmy : (bf16_t*)(ws + WS_GVT), (const float*)(ws + WS_RSS2)}; pg8::gemm_phase<EpiVT<DRY>>(lds, g, S, E); }
}
template <bool DRY> __device__ __forceinline__ void ph6(const Args& a, LAS unsigned char* lds) {
    unsigned char* ws = a.ws; unsigned char* dmy = ws + WS_DUMMY; const int G = gridDim.x, bid = blockIdx.x;
    pg8::Gemm g{(const bf16_t*)(ws + WS_XB), (const bf16_t*)(ws + WS_WBT) + (size_t)4096 * DM, MT, 2048, DM}; pg8::StaticOrder S; S.init(MT, 2048, G, bid);
    EpiZ<DRY> E{(const bf16_t*)(ws + WS_Q), DRY ? (bf16_t*)dmy : (bf16_t*)(ws + WS_Q), (const float*)(ws + WS_RSS2)}; pg8::gemm_phase<EpiZ<DRY>>(lds, g, S, E);
}
template <bool DRY> __device__ __forceinline__ void ph7(const Args& a, LAS unsigned char* lds) {
    unsigned char* ws = a.ws; unsigned char* dmy = ws + WS_DUMMY; const int G = gridDim.x, bid = blockIdx.x;
    pg8::Gemm g{(const bf16_t*)(ws + WS_Q), (const bf16_t*)(ws + WS_WOT), MT, DM, EW}; pg8::StaticOrder S; S.init(MT, DM, G, bid);
    EpiH2<DRY> E{(const bf16_t*)(ws + WS_XB), DRY ? (bf16_t*)dmy : (bf16_t*)(ws + WS_UZ), DRY ? (float*)dmy + (1 << 23) : (float*)(ws + WS_RSS3)}; pg8::gemm_phase<EpiH2<DRY>>(lds, g, S, E);
}

#define XB_TMO      128
#define XB_XCNT(j)  (256  + 64 * (j))
#define XB_XSUB(j)  (1280 + 64 * (j))
#define XB_XGEN(j)  (2304 + 64 * (j))
#define XB_TOP      3328
#define XB_TOPGEN   3392
#define XCD_BAR_WORDS 3456
#define XB_SPIN_CAP (1u << 18)
__device__ __forceinline__ unsigned xb_ld(unsigned* p)              { return __hip_atomic_load(p, __ATOMIC_RELAXED, __HIP_MEMORY_SCOPE_AGENT); }
__device__ __forceinline__ unsigned xb_add(unsigned* p, unsigned v) { return __hip_atomic_fetch_add(p, v, __ATOMIC_RELAXED, __HIP_MEMORY_SCOPE_AGENT); }
__device__ __forceinline__ unsigned xb_xcc_id() { return (unsigned)__builtin_amdgcn_s_getreg((3 << 11) | 20) & 0xFu; }
#define XB_SPIN(cond, bar) do { unsigned _sp = 0; while (cond) { __builtin_amdgcn_s_sleep(1); \
    if ((++_sp & 255u) == 0u) { if (xb_ld(&(bar)[XB_TMO])) break; if (_sp > XB_SPIN_CAP) { atomicAdd(&(bar)[XB_TMO], 1u); break; } } } } while (0)
struct XcdBarrier { unsigned* bar; unsigned x; volatile LAS unsigned* st; };
__device__ __forceinline__ XcdBarrier xcd_barrier_post(unsigned* bar, volatile LAS unsigned* st) {
    XcdBarrier b; b.bar = bar; b.x = xb_xcc_id(); b.st = st;
    if (threadIdx.x == 0) (void)xb_add(&bar[XB_XCNT(b.x)], 1u);
    return b;
}
__device__ __forceinline__ void xcd_barrier_complete(unsigned* bar, unsigned x, unsigned& nloc, unsigned& nx) {
    const unsigned G = gridDim.x * gridDim.y * gridDim.z;
    unsigned sum, cnt, mine, sp = 0u;
    for (;;) {
        sum = 0u; cnt = 0u; mine = 0u;
#pragma unroll
        for (unsigned j = 0; j < 16; ++j) { const unsigned c = xb_ld(&bar[XB_XCNT(j)]); sum += c; cnt += (c > 0u) ? 1u : 0u; mine = (j == x) ? c : mine; }
        if (sum == G) break;
        __builtin_amdgcn_s_sleep(1);
        if ((++sp & 255u) == 0u) { if (xb_ld(&bar[XB_TMO])) break; if (sp > XB_SPIN_CAP) { atomicAdd(&bar[XB_TMO], 1u); break; } }
    }
    nloc = mine > 0u ? mine : 1u; nx = cnt > 0u ? cnt : 1u;
}
__device__ __forceinline__ void xcd_barrier(const XcdBarrier& b) {
    asm volatile("s_waitcnt vmcnt(0)" ::: "memory");
    __syncthreads();
    if (threadIdx.x == 0) {
        unsigned* bar = b.bar;
        __builtin_amdgcn_s_waitcnt(0);
        unsigned nloc = b.st[0], nx = b.st[1];
        if (nloc == 0u) { xcd_barrier_complete(bar, b.x, nloc, nx); b.st[0] = nloc; b.st[1] = nx; }
        const unsigned old = xb_add(&bar[XB_XSUB(b.x)], 1u);
        const unsigned gen = old / nloc;
        if (old + 1u == (gen + 1u) * nloc) {
            __builtin_amdgcn_fence(__ATOMIC_RELEASE, "agent");
            asm volatile("s_waitcnt vmcnt(0)" ::: "memory");
            const unsigned og = xb_add(&bar[XB_TOP], 1u);
            const unsigned tg = og / nx;
            if (og + 1u == (tg + 1u) * nx) xb_add(&bar[XB_TOPGEN], 1u);
            else XB_SPIN(xb_ld(&bar[XB_TOPGEN]) == tg, bar);
            __builtin_amdgcn_fence(__ATOMIC_ACQUIRE, "agent");
            xb_add(&bar[XB_XGEN(b.x)], 1u);
            asm volatile("s_waitcnt vmcnt(0)" ::: "memory");
        } else {
            XB_SPIN(xb_ld(&bar[XB_XGEN(b.x)]) == gen, bar);
            __builtin_amdgcn_fence(__ATOMIC_ACQUIRE, "agent");
            asm volatile("s_waitcnt vmcnt(0)" ::: "memory");
        }
    }
    __syncthreads();
}

__global__ void __launch_bounds__(512, 2) yoco_fwd(Args a) {
    extern __shared__ __attribute__((aligned(16))) unsigned char lds_raw[];
    LAS unsigned char* lds = (LAS unsigned char*)lds_raw;
    cg::grid_group grid = cg::this_grid();
    unsigned char* ws = a.ws;
    const int lo = a.ph_lo, hi = a.ph_hi;
    volatile LAS unsigned* xst = (volatile LAS unsigned*)(lds + XB_ST_OFF);
    if (threadIdx.x < 4) xst[threadIdx.x] = 0u;
    __syncthreads();
    const XcdBarrier xb = xcd_barrier_post((unsigned*)(ws + WS_BAR), xst);
#define IN(k) (lo <= (k) && (k) < hi)
#define SEAM(k) do { if (IN(k) && IN((k) + 1)) xcd_barrier(xb); } while (0)
    if (a.ph_hi > 1000) grid.sync();
#define RUN(k, F) do { if (IN(k)) { if constexpr ((PROBE_MASK >> (k)) & 1) F<true>(a, lds); F<false>(a, lds); } } while (0)
    if (IN(0)) { if (PROBE_MASK & 1) p0_prologue(a, lds); p0_prologue(a, lds); }
    SEAM(0);
    RUN(1, ph1); SEAM(1);
    RUN(2, p2_spatial); SEAM(2);
    RUN(3, ph3); SEAM(3);
    RUN(4, ph4); SEAM(4);
    RUN(5, p5_attention); if (IN(5) && IN(7)) grid.sync();
    RUN(7, ph7); SEAM(7);
    RUN(8, p8_final);
#undef RUN
#undef IN
#undef SEAM
}

#ifndef N_LAUNCHES
#define N_LAUNCHES 1
#endif
extern "C" void kernel_launch(void* const* d_in, const int* in_sizes, int n_in, void* d_out, int out_size, void* d_ws, size_t ws_size, hipStream_t stream) {
    static int grid = 0;
    if (grid == 0) {
        if (n_in != 19 || out_size != MT * DM || ws_size < WS_END + ((size_t)64 << 20)) { fprintf(stderr, "kernel_launch: unexpected shapes (n_in %d out %d ws %zu need %zu)\n", n_in, out_size, ws_size, (size_t)WS_END); grid = -1; return; }
        int dev = 0, cus = 0, per_cu = 0;
        if (hipGetDevice(&dev) != hipSuccess || hipDeviceGetAttribute(&cus, hipDeviceAttributeMultiprocessorCount, dev) != hipSuccess) { grid = -1; return; }
        if (hipFuncSetAttribute((const void*)yoco_fwd, hipFuncAttributeMaxDynamicSharedMemorySize, LDS_BYTES) != hipSuccess) { fprintf(stderr, "kernel_launch: hipFuncSetAttribute failed\n"); grid = -1; return; }
        if (hipOccupancyMaxActiveBlocksPerMultiprocessor(&per_cu, (const void*)yoco_fwd, 512, LDS_BYTES) != hipSuccess || per_cu < 1) { fprintf(stderr, "kernel_launch: occupancy query says %d\n", per_cu); per_cu = 1; }
        (void)hipGetLastError();
        grid = cus;
    }
    if (grid < 0) return;
    Args a{};
    for (int i = 0; i < 19; ++i) a.in[i] = (const float*)d_in[i];
    a.out = (float*)d_out; a.ws = (unsigned char*)d_ws; a.rep = PROBE_MASK;
    (void)hipMemsetAsync((char*)d_ws + WS_BAR, 0, XCD_BAR_WORDS * sizeof(unsigned), stream);
#if N_LAUNCHES == 1
    a.ph_lo = 0; a.ph_hi = 9;
    void* args[] = {&a};
    hipError_t e = hipLaunchCooperativeKernel((const void*)yoco_fwd, dim3(grid), dim3(512), args, LDS_BYTES, stream);
    if (e != hipSuccess) fprintf(stderr, "cooperative launch failed: %s (grid %d)\n", hipGetErrorString(e), grid);
#else
    for (int p = 0; p < 9; ++p) { a.ph_lo = p; a.ph_hi = p + 1; hipLaunchKernelGGL(yoco_fwd, dim3(grid), dim3(512), LDS_BYTES, stream, a); }
#endif
}
```
